# Optimizing an MI355X kernel written in HIP

```python
import jax, jax.numpy as jnp
from jax import lax
import numpy as np

D_MODEL = 2048
BATCH = 4
SEQ = 4096
DEPTH = 2

N_EVEN = (DEPTH + 1) // 2
N_ODD = DEPTH // 2
EPS = 1e-6

CONV_DIM = 1024
CONV_WIDTH = 3
MLA_HEADS = 8
Q_LORA = 512
KV_LORA = 256
QK_NOPE = 128
QK_ROPE = 64
V_HEAD = 128
ROPE_THETA = 10000.0
Q_BLOCK = 128
IN_COLS = 3 * CONV_DIM + Q_LORA + KV_LORA + QK_ROPE
MIX_OUT = CONV_DIM + MLA_HEADS * V_HEAD
POOL_WINDOWS = (2, 4, 8, 16)
POOL_GROUPS = 4
POOL_DIM = D_MODEL // POOL_GROUPS
D_FF_DENSE = 5632
N_EXPERTS = 8
TOP_K = 2
D_FF_EXPERT = 2816

kernel_name = "hybrid_conv_mla_pool_moe_block"


def rmsnorm(x, g):
    xf = x.astype(jnp.float32)
    y = xf * lax.rsqrt(jnp.mean(xf * xf, axis=-1, keepdims=True) + EPS)
    return (y * g.astype(jnp.float32)).astype(x.dtype)


def swiglu(h, w_gate, w_up, w_down):
    return (jax.nn.silu(h @ w_gate) * (h @ w_up)) @ w_down


def causal_short_conv(u, w):
    S = u.shape[1]
    up = jnp.pad(u, ((0, 0), (CONV_WIDTH - 1, 0), (0, 0)))
    return sum(w[j] * up[:, j:j + S] for j in range(CONV_WIDTH))


def rope(t, cos, sin):
    half = t.shape[-1] // 2
    tf = t.astype(jnp.float32)
    t1, t2 = tf[..., :half], tf[..., half:]
    return jnp.concatenate([t1 * cos - t2 * sin, t1 * sin + t2 * cos], axis=-1).astype(t.dtype)


def causal_block_attention(q_nope, q_rope, k_nope, k_rope, v):
    B, S, H, _ = q_nope.shape
    nb = S // Q_BLOCK
    scale = (QK_NOPE + QK_ROPE) ** -0.5
    key_pos = jnp.arange(S)

    def to_blocks(t):
        return jnp.moveaxis(t.reshape(B, nb, Q_BLOCK, *t.shape[2:]), 1, 0)

    def one_block(args):
        qn, qr, start = args
        s = (jnp.einsum('bqhd,bkhd->bhqk', qn, k_nope, preferred_element_type=jnp.float32)
             + jnp.einsum('bqhd,bkd->bhqk', qr, k_rope, preferred_element_type=jnp.float32))
        q_pos = start + jnp.arange(Q_BLOCK)
        mask = key_pos[None, :] <= q_pos[:, None]
        s = jnp.where(mask, s * scale, -jnp.inf)
        p = jax.nn.softmax(s, axis=-1).astype(v.dtype)
        return jnp.einsum('bhqk,bkhd->bqhd', p, v)

    starts = jnp.arange(nb) * Q_BLOCK
    out = lax.map(one_block, (to_blocks(q_nope), to_blocks(q_rope), starts))
    return jnp.moveaxis(out, 0, 1).reshape(B, S, H * V_HEAD)


def conv_mla_mixer(h, cos, sin, w_in, conv_w, q_norm, w_uq, kv_norm, w_ukv, w_out):
    B, S, _ = h.shape
    proj = h @ w_in
    o = np.cumsum([0, CONV_DIM, CONV_DIM, CONV_DIM, Q_LORA, KV_LORA, QK_ROPE])
    x_in, gate_b, gate_c, c_q, c_kv, k_r = [proj[..., o[i]:o[i + 1]] for i in range(6)]
    y_a = gate_b * causal_short_conv(gate_c * x_in, conv_w)
    q = (rmsnorm(c_q, q_norm) @ w_uq).reshape(B, S, MLA_HEADS, QK_NOPE + QK_ROPE)
    kv = (rmsnorm(c_kv, kv_norm) @ w_ukv).reshape(B, S, MLA_HEADS, QK_NOPE + V_HEAD)
    q_nope, q_rope = q[..., :QK_NOPE], rope(q[..., QK_NOPE:], cos[:, None, :], sin[:, None, :])
    k_nope, v = kv[..., :QK_NOPE], kv[..., QK_NOPE:]
    k_rope = rope(k_r, cos, sin)
    y_b = causal_block_attention(q_nope, q_rope, k_nope, k_rope, v)
    return jnp.concatenate([y_a, y_b], axis=-1) @ w_out


def multiscale_pool_mixer(h, pool_w, pool_scale):
    B, S, D = h.shape
    hg = h.reshape(B, S, POOL_GROUPS, POOL_DIM).astype(jnp.float32)
    cz = jnp.concatenate([jnp.zeros((B, 1, POOL_GROUPS, POOL_DIM), jnp.float32),
                          jnp.cumsum(hg, axis=1)], axis=1)
    t = jnp.arange(S)
    means = []
    for g, w in enumerate(POOL_WINDOWS):
        c = cz[:, :, g]
        upper = c[:, 1:]
        lower = jnp.concatenate([jnp.zeros((B, w - 1, POOL_DIM), jnp.float32), c[:, :S - w + 1]], axis=1)
        count = jnp.minimum(t + 1, w).astype(jnp.float32)[None, :, None]
        means.append((upper - lower) / count)
    pooled = (jnp.stack(means, axis=2) - hg).astype(h.dtype)
    y = jnp.einsum('bsgc,gcd->bsgd', pooled, pool_w).reshape(B, S, D)
    return y * pool_scale


def moe_swiglu(h, router_w, w_gate, w_up, w_down):
    logits = jnp.einsum('bsd,de->bse', h, router_w, preferred_element_type=jnp.float32)
    top_v, top_i = lax.top_k(logits, TOP_K)
    top_p = jax.nn.softmax(top_v, axis=-1)
    gates = jnp.sum(jax.nn.one_hot(top_i, N_EXPERTS, dtype=jnp.float32) * top_p[..., None],
                    axis=-2).astype(h.dtype)
    y = jnp.zeros_like(h)
    for e in range(N_EXPERTS):
        y = y + gates[..., e:e + 1] * swiglu(h, w_gate[e], w_up[e], w_down[e])
    return y


def setup_inputs(seed: int = 0) -> dict:
    key = jax.random.key(seed)
    ks = jax.random.split(key, 24)

    def w(k, shape, fan_in):
        return jax.random.normal(k, shape, jnp.float32) * fan_in ** -0.5

    def gain(k, shape):
        return 1.0 + 0.02 * jax.random.normal(k, shape, jnp.float32)

    E, O = N_EVEN, N_ODD
    return {
        "x": jax.random.normal(ks[0], (BATCH, SEQ, D_MODEL), jnp.float32),
        "norm_mix0": gain(ks[1], (E, D_MODEL)),
        "w_in": w(ks[2], (E, D_MODEL, IN_COLS), D_MODEL),
        "conv_w": w(ks[3], (E, CONV_WIDTH, CONV_DIM), CONV_WIDTH),
        "q_norm": gain(ks[4], (E, Q_LORA)),
        "w_uq": w(ks[5], (E, Q_LORA, MLA_HEADS * (QK_NOPE + QK_ROPE)), Q_LORA),
        "kv_norm": gain(ks[6], (E, KV_LORA)),
        "w_ukv": w(ks[7], (E, KV_LORA, MLA_HEADS * (QK_NOPE + V_HEAD)), KV_LORA),
        "w_out": w(ks[8], (E, MIX_OUT, D_MODEL), MIX_OUT),
        "norm_ffn0": gain(ks[9], (E, D_MODEL)),
        "ffn_w_gate": w(ks[10], (E, D_MODEL, D_FF_DENSE), D_MODEL),
        "ffn_w_up": w(ks[11], (E, D_MODEL, D_FF_DENSE), D_MODEL),
        "ffn_w_down": w(ks[12], (E, D_FF_DENSE, D_MODEL), D_FF_DENSE),
        "norm_mix1": gain(ks[13], (O, D_MODEL)),
        "pool_w": w(ks[14], (O, POOL_GROUPS, POOL_DIM, POOL_DIM), POOL_DIM),
        "pool_scale": gain(ks[15], (O, D_MODEL)),
        "norm_ffn1": gain(ks[16], (O, D_MODEL)),
        "router_w": w(ks[17], (O, D_MODEL, N_EXPERTS), D_MODEL),
        "moe_w_gate": w(ks[18], (O, N_EXPERTS, D_MODEL, D_FF_EXPERT), D_MODEL),
        "moe_w_up": w(ks[19], (O, N_EXPERTS, D_MODEL, D_FF_EXPERT), D_MODEL),
        "moe_w_down": w(ks[20], (O, N_EXPERTS, D_FF_EXPERT, D_MODEL), D_FF_EXPERT),
        "final_norm": gain(ks[21], (D_MODEL,)),
    }


def reference(x, norm_mix0, w_in, conv_w, q_norm, w_uq, kv_norm, w_ukv, w_out,
              norm_ffn0, ffn_w_gate, ffn_w_up, ffn_w_down,
              norm_mix1, pool_w, pool_scale, norm_ffn1, router_w,
              moe_w_gate, moe_w_up, moe_w_down, final_norm):
    S = x.shape[1]
    pos = jnp.arange(S, dtype=jnp.float32)
    inv_freq = ROPE_THETA ** (-jnp.arange(0, QK_ROPE, 2, dtype=jnp.float32) / QK_ROPE)
    ang = pos[:, None] * inv_freq[None, :]
    cos, sin = jnp.cos(ang), jnp.sin(ang)

    for layer in range(DEPTH):
        i = layer // 2
        if layer % 2 == 0:
            h = rmsnorm(x, norm_mix0[i])
            x = x + conv_mla_mixer(h, cos, sin, w_in[i], conv_w[i], q_norm[i], w_uq[i],
                                   kv_norm[i], w_ukv[i], w_out[i])
            h = rmsnorm(x, norm_ffn0[i])
            x = x + swiglu(h, ffn_w_gate[i], ffn_w_up[i], ffn_w_down[i])
        else:
            h = rmsnorm(x, norm_mix1[i])
            x = x + multiscale_pool_mixer(h, pool_w[i], pool_scale[i])
            h = rmsnorm(x, norm_ffn1[i])
            x = x + moe_swiglu(h, router_w[i], moe_w_gate[i], moe_w_up[i], moe_w_down[i])
    return rmsnorm(x, final_norm)
```

```cpp
#include <hip/hip_runtime.h>
#include <cstdio>
#include <cstdint>
#include <cmath>

#ifndef MK_PER_PHASE
#define MK_PER_PHASE 0
#endif
#ifndef PROBE_MASK
#define PROBE_MASK 0
#endif
#ifndef OVERLAP_CONV
#define OVERLAP_CONV 1
#endif
#ifndef FFN_UP_FP8
#define FFN_UP_FP8 0
#endif
#ifndef FFN_UP_I8
#define FFN_UP_I8 1
#endif
#ifndef RES_BF16
#define RES_BF16 1
#endif
#ifndef I8_PERCOL
#define I8_PERCOL 1
#endif
#ifndef FOLD_QKV_NORM
#define FOLD_QKV_NORM 1
#endif
#ifndef FFN_DN_FP8
#define FFN_DN_FP8 0
#endif

#define LAS __attribute__((address_space(3)))
#define GAS __attribute__((address_space(1)))
typedef unsigned short bf16_t;
typedef short bf16x8 __attribute__((ext_vector_type(8)));
typedef short s16x4 __attribute__((ext_vector_type(4)));
typedef float f32x2 __attribute__((ext_vector_type(2)));
typedef float f32x4 __attribute__((ext_vector_type(4)));
typedef float f32x16 __attribute__((ext_vector_type(16)));
typedef unsigned u32x2 __attribute__((ext_vector_type(2)));
typedef unsigned u32x4 __attribute__((ext_vector_type(4)));
typedef int i32x4 __attribute__((ext_vector_type(4)));
typedef int i32x8 __attribute__((ext_vector_type(8)));

constexpr int DM = 2048, SEQ = 4096, M = 16384;
constexpr int CONV = 1024, NH = 8, QLORA = 512, KVLORA = 256, QKD = 192;
constexpr int INC = 3904, INP = 4096;
constexpr int FF = 5632, NE = 8, FE = 2816;
constexpr int MOE_ROWS = 2 * M + NE * 256;
constexpr int MOE_TILES = MOE_ROWS / 256;
constexpr float EPS = 1e-6f;
constexpr float QSCALE = 0.07216878364870322f * 1.4426950408889634f;
constexpr int NWAVES = 8, NTHREADS = 512;

constexpr size_t MiB = 1u << 20;
constexpr size_t WS_CTL = 0, CTL_ZERO_BYTES = 1 * MiB;
constexpr size_t WS_ROPE = 1 * MiB;
constexpr size_t WS_MISC = 2 * MiB;
constexpr size_t WS_W_IN = 4 * MiB;
constexpr size_t WS_W_UQ = WS_W_IN + 16 * MiB;
constexpr size_t WS_W_UKV = WS_W_UQ + 2 * MiB;
constexpr size_t WS_W_OUT = WS_W_UKV + 1 * MiB;
constexpr size_t WS_W_GU = WS_W_OUT + 8 * MiB;
constexpr size_t WS_W_DN = WS_W_GU + 44 * MiB;
constexpr size_t WS_W_POOL = WS_W_DN + 22 * MiB;
constexpr size_t WS_W_MGU = WS_W_POOL + 2 * MiB;
constexpr size_t WS_W_MDN = WS_W_MGU + 88 * MiB;
constexpr size_t WS_XBA = WS_W_MDN + 44 * MiB;
constexpr size_t WS_XBB = WS_XBA + 64 * MiB;
constexpr size_t WS_R0 = WS_XBB + 64 * MiB;
constexpr size_t WS_PROJ = WS_R0;
constexpr size_t WS_Q = WS_R0 + 220 * MiB;
constexpr size_t WS_KN = WS_R0 + 268 * MiB;
constexpr size_t WS_CQ = WS_R0 + 96 * MiB;
constexpr size_t WS_CKV = WS_R0 + 112 * MiB;
constexpr size_t WS_KR = WS_R0 + 120 * MiB;
constexpr size_t WS_V = WS_R0 + 124 * MiB;
constexpr size_t WS_YAB = WS_R0 + 156 * MiB;
constexpr size_t WS_H = WS_R0;
constexpr size_t WS_HMOE = WS_R0;
constexpr size_t WS_YMOE = WS_R0 + 188 * MiB;
constexpr size_t WS_SSQ = WS_R0 + 316 * MiB;
constexpr size_t WS_XRB = WS_SSQ + 2 * MiB;
constexpr size_t WS_END = WS_XRB + 64 * MiB;
constexpr size_t MS_TOPI = 0, MS_TOPP = 128 * 1024, MS_CNT = 256 * 1024, MS_PERM = 272 * 1024, MS_GATE = 416 * 1024, MS_DEST = 560 * 1024, MS_TILE = 704 * 1024;
constexpr int CW_BAR = 4096, CW_DIAG = 16384, CW_WMAX = 8192;
constexpr size_t MS_SSQ2 = 1024 * 1024;
constexpr size_t MS_WSC = 832 * 1024;
constexpr size_t MS_ASC = 768 * 1024;

constexpr int RING_BYTES = 131072;
constexpr int LX_BAR = RING_BYTES;
constexpr int LX_TILE = RING_BYTES + 256;
constexpr int LDS_BYTES = 147456;

__device__ __forceinline__ unsigned cvt_pk_bf16(float lo, float hi) { unsigned r; asm volatile("v_cvt_pk_bf16_f32 %0, %1, %2" : "=v"(r) : "v"(lo), "v"(hi)); return r; }
__device__ __forceinline__ float bf2f(unsigned short b) { return __uint_as_float((unsigned)b << 16); }
__device__ __forceinline__ float bflo(unsigned w) { return __uint_as_float(w << 16); }
__device__ __forceinline__ float bfhi(unsigned w) { return __uint_as_float(w & 0xffff0000u); }
__device__ __forceinline__ float wave_sum(float v) {
#pragma unroll
    for (int o = 1; o < 64; o <<= 1) v += __shfl_xor(v, o);
    return v;
}
__device__ __forceinline__ u32x4 pack8(f32x4 a, f32x4 b) { u32x4 w; w.x = cvt_pk_bf16(a[0], a[1]); w.y = cvt_pk_bf16(a[2], a[3]); w.z = cvt_pk_bf16(b[0], b[1]); w.w = cvt_pk_bf16(b[2], b[3]); return w; }
#if RES_BF16
typedef bf16_t res_t;
#else
typedef float res_t;
#endif
__device__ __forceinline__ f32x4 ldrow4(const float* p) { return *(const f32x4*)p; }
__device__ __forceinline__ f32x4 ldrow4(const bf16_t* p) { const u32x2 w = *(const u32x2*)p; return (f32x4){__uint_as_float(w.x << 16), __uint_as_float(w.x & 0xffff0000u), __uint_as_float(w.y << 16), __uint_as_float(w.y & 0xffff0000u)}; }
__device__ __forceinline__ f32x4 ldres4(const res_t* p) {
#if RES_BF16
    const u32x2 w = *(const u32x2*)p; return (f32x4){bflo(w.x), bfhi(w.x), bflo(w.y), bfhi(w.y)};
#else
    return *(const f32x4*)p;
#endif
}
#define LDS_WAIT() asm volatile("s_waitcnt lgkmcnt(0)" ::: "memory")
#define VM_WAIT() asm volatile("s_waitcnt vmcnt(0)" ::: "memory")

namespace pg8 {
constexpr int BM = 256, BK = 64, HALF = 128, HTB = HALF * BK * 2, STAGE_BYTES = 8 * HTB, NXCD = 8, WGM = 8;
__host__ __device__ __forceinline__ int lds_byte(int r, int c) { const int st = (r >> 4) * 2 + (c >> 5), rr = r & 15, cc = c & 31, ob = rr * 64 + cc * 2; return st * 1024 + (ob ^ (((ob >> 9) & 1) << 5)); }
__host__ __device__ __forceinline__ void stage_rc(int b, int& R, int& C) { const int st = b / 1024, sb = b % 1024, swz = sb ^ (((sb >> 9) & 1) << 5); R = (st >> 1) * 16 + swz / 64; C = (st & 1) * 32 + (swz % 64) / 2; }
__host__ __device__ __forceinline__ int perm32(int rho) { const int n = rho >> 4, i = rho & 15; return 8 * (i >> 2) + 4 * n + (i & 3); }

struct Unit { int pm, pn, e; size_t a_off, b_off; const int* rows; };
struct GemmDesc { const bf16_t* A; const bf16_t* Bt; int lda, ldb, K; int sc_w, sc_a; };

__device__ __forceinline__ void order_decode(long L, int nwg, int nM, int nN, int& pm, int& pn) {
    int wgid = (int)L; { const int q = nwg / NXCD, r = nwg % NXCD, xcd = wgid % NXCD, off = wgid / NXCD; wgid = (xcd < r ? xcd * (q + 1) : r * (q + 1) + (xcd - r) * q) + off; }
    const int nig = WGM * nN, gid = wgid / nig, fm = gid * WGM, gsz = (nM - fm) < WGM ? (nM - fm) : WGM;
    pm = fm + ((wgid % nig) % gsz); pn = (wgid % nig) / gsz;
}
struct StaticOrder {
    int nM, nN, nwg, G, c, lda, ldb, grp_div, grp_cols;
    __device__ __forceinline__ void init(int nM_, int nN_, int G_, int c_, int lda_, int ldb_, int gd = 0, int gc = 0) { nM = nM_; nN = nN_; nwg = nM * nN; G = G_; c = c_; lda = lda_; ldb = ldb_; grp_div = gd; grp_cols = gc; }
    __device__ __forceinline__ bool next(int i, Unit& u) const {
        const long L = (long)i * G + c; if (L >= nwg) return false;
        order_decode(L, nwg, nM, nN, u.pm, u.pn);
        u.a_off = (size_t)u.pm * BM * lda + (grp_div ? (size_t)(u.pn / grp_div) * grp_cols : 0);
        u.b_off = (size_t)u.pn * BM * ldb; u.rows = nullptr; u.e = 0; return true;
    }
};
struct MoeOrder {
    int nM, nN, nwg, G, c, lda, ldb; size_t estride; const LAS int* tile_e; const int* rows_base; bool gather;
    __device__ __forceinline__ bool next(int i, Unit& u) const {
        const long L = (long)i * G + c; if (L >= nwg) return false;
        order_decode(L, nwg, nM, nN, u.pm, u.pn);
        u.e = __builtin_amdgcn_readfirstlane(tile_e[u.pm]);
        u.a_off = gather ? 0 : (size_t)u.pm * BM * lda;
        u.b_off = (size_t)u.e * estride + (size_t)u.pn * BM * ldb; u.rows = rows_base + u.pm * BM; return true;
    }
};

template <class Epi, class Sched, bool ALIGN_EPI, bool GATHER, int MODE = 0>
__device__ __forceinline__ void gemm_phase(LAS unsigned char* lds, const GemmDesc g, const Sched& S, const Epi& E, const int tid) {
    const int wid = __builtin_amdgcn_readfirstlane(tid >> 6), lane = tid & 63, wr = wid >> 2, wc = wid & 3, fr = lane & 15, fq = lane >> 4;
    constexpr bool FP8 = (MODE == 1), I8 = (MODE == 2);
    const int K = g.K, nt = K / BK;
    unsigned voffA[2], voffB[2], ca2[2]; int ra[2];
#pragma unroll
    for (int i = 0; i < 2; ++i) { int R, C; stage_rc(tid * 16 + i * 8192, R, C); const int Rb = Epi::PERM ? ((R & ~31) + perm32(R & 31)) : R;
        voffA[i] = (unsigned)(R * g.lda + C) * 2u; voffB[i] = (unsigned)(Rb * g.ldb + C) * 2u; ra[i] = R; ca2[i] = (unsigned)C * 2u; }
    const size_t kstep = (size_t)(BK * 2);
    const size_t hstepA = (size_t)HALF * g.lda * 2, hstepB = (size_t)HALF * g.ldb * 2;
    const unsigned ldsw = (unsigned)wid * 1024u;
    const int aoff = lds_byte(wr * 64 + fr, fq * 8), boff = lds_byte(wc * 32 + fr, fq * 8);
    unsigned vgC[2][2], vgN[2][2];
#define PG8_SA(b, h) (((b) * 2 + (h)) * HTB)
#define PG8_SB(b, h) ((4 + (b) * 2 + (h)) * HTB)
#define PG8_GLDS(src, bufoff, i) __builtin_amdgcn_global_load_lds((const unsigned*)(src), (LAS unsigned*)(lds + (bufoff) + ldsw + (i) * 8192), 16, 0, 0)
#define PG8_STAGE_B(bufoff, gbase) do { _Pragma("unroll") for (int _i = 0; _i < 2; ++_i) PG8_GLDS((const char*)(gbase) + voffB[_i], bufoff, _i); } while (0)
#define PG8_STAGE_A(bufoff, gbase, h, nx) do { _Pragma("unroll") for (int _i = 0; _i < 2; ++_i) { \
        if constexpr (GATHER) { PG8_GLDS((const char*)(gbase) + ((nx) ? vgN[h][_i] : vgC[h][_i]), bufoff, _i); } \
        else { PG8_GLDS((const char*)(gbase) + (size_t)(h) * hstepA + voffA[_i], bufoff, _i); } } } while (0)
#define PG8_LDA(b, h) do { _Pragma("unroll") for (int m = 0; m < 4; ++m) { \
        if constexpr (FP8) { const i32x4 lo_ = *(const LAS i32x4*)(lds + PG8_SA(b, h) + aoff + m * 2048), hi_ = *(const LAS i32x4*)(lds + PG8_SA(b, h) + aoff + m * 2048 + 1024); At8[m] = __builtin_shufflevector(lo_, hi_, 0, 1, 2, 3, 4, 5, 6, 7); } \
        else { _Pragma("unroll") for (int k = 0; k < 2; ++k) At[m][k] = *(const LAS bf16x8*)(lds + PG8_SA(b, h) + aoff + m * 2048 + k * 1024); } } } while (0)
#define PG8_LDB(W, b, h) do { _Pragma("unroll") for (int n = 0; n < 2; ++n) { \
        if constexpr (FP8) { const i32x4 lo_ = *(const LAS i32x4*)(lds + PG8_SB(b, h) + boff + n * 2048), hi_ = *(const LAS i32x4*)(lds + PG8_SB(b, h) + boff + n * 2048 + 1024); B8[W][n] = __builtin_shufflevector(lo_, hi_, 0, 1, 2, 3, 4, 5, 6, 7); } \
        else { _Pragma("unroll") for (int k = 0; k < 2; ++k) Bq[W][n][k] = *(const LAS bf16x8*)(lds + PG8_SB(b, h) + boff + n * 2048 + k * 1024); } } } while (0)
#define PG8_MMA(ai, bj) do { __builtin_amdgcn_s_setprio(1); _Pragma("unroll") for (int m = 0; m < 4; ++m) _Pragma("unroll") for (int n = 0; n < 2; ++n) { \
        if constexpr (FP8) { asm volatile("v_mfma_scale_f32_16x16x128_f8f6f4 %0, %1, %2, %0, %3, %4 op_sel_hi:[0,0,0]" : "+v"(acc[ai][bj][m][n]) : "v"(B8[bj][n]), "v"(At8[m]), "v"(scw), "v"(sca)); } \
        else if constexpr (I8) { _Pragma("unroll") for (int k = 0; k < 2; ++k) acc[ai][bj][m][n] = __builtin_bit_cast(f32x4, __builtin_amdgcn_mfma_i32_16x16x64_i8(__builtin_bit_cast(i32x4, Bq[bj][n][k]), __builtin_bit_cast(i32x4, At[m][k]), __builtin_bit_cast(i32x4, acc[ai][bj][m][n]), 0, 0, 0)); } \
        else { _Pragma("unroll") for (int k = 0; k < 2; ++k) acc[ai][bj][m][n] = __builtin_amdgcn_mfma_f32_16x16x32_bf16(Bq[bj][n][k], At[m][k], acc[ai][bj][m][n], 0, 0, 0); } } \
        __builtin_amdgcn_s_setprio(0); } while (0)
#define PG8_WAIT_V(n) asm volatile("s_waitcnt vmcnt(" #n ")" ::: "memory")
#define PG8_WAIT_L(n) asm volatile("s_waitcnt lgkmcnt(" #n ")" ::: "memory")
#define PG8_BAR __builtin_amdgcn_s_barrier()
#define PG8_SCHED __builtin_amdgcn_sched_barrier(0)
#define PG8_VG(dst, u) do { _Pragma("unroll") for (int _h = 0; _h < 2; ++_h) _Pragma("unroll") for (int _i = 0; _i < 2; ++_i) dst[_h][_i] = (unsigned)(u).rows[_h * HALF + ra[_i]] * (unsigned)(g.lda * 2) + ca2[_i]; } while (0)
    Unit cur, nxt; int ui = 0;
    if (!S.next(0, cur)) return;
    const int scw = g.sc_w, sca = g.sc_a; (void)scw; (void)sca;
    f32x4 acc[2][2][4][2];
#pragma unroll
    for (int a = 0; a < 2; ++a)
#pragma unroll
        for (int b = 0; b < 2; ++b)
#pragma unroll
            for (int m = 0; m < 4; ++m)
#pragma unroll
                for (int n = 0; n < 2; ++n) acc[a][b][m][n] = (f32x4){0.f, 0.f, 0.f, 0.f};
    bf16x8 At[4][2], Bq[2][2][2]; i32x8 At8[4], B8[2][2]; (void)At; (void)Bq; (void)At8; (void)B8;
    const char* cA = (const char*)g.A + cur.a_off * 2; const char* cB = (const char*)g.Bt + cur.b_off * 2;
    if constexpr (GATHER) { PG8_VG(vgC, cur); PG8_VG(vgN, cur); }
    PG8_STAGE_B(PG8_SB(0, 0), cB); PG8_STAGE_B(PG8_SB(0, 1), cB + hstepB); PG8_STAGE_A(PG8_SA(0, 0), cA, 0, false); PG8_STAGE_A(PG8_SA(0, 1), cA, 1, false);
    if (wr == 1) PG8_BAR;
    PG8_WAIT_V(2); PG8_BAR;
    PG8_STAGE_B(PG8_SB(1, 0), cB + kstep); PG8_STAGE_A(PG8_SA(1, 0), cA + kstep, 0, false); PG8_STAGE_B(PG8_SB(1, 1), cB + hstepB + kstep);
    PG8_WAIT_V(6); PG8_BAR;
    for (;;) {
        const bool has_next = S.next(ui + 1, nxt);
        const char* nA = has_next ? (const char*)g.A + nxt.a_off * 2 : cA; const char* nB = has_next ? (const char*)g.Bt + nxt.b_off * 2 : cB;
        if constexpr (GATHER) { if (has_next) { PG8_VG(vgN, nxt); } else {
#pragma unroll
            for (int _h = 0; _h < 2; ++_h) { vgN[_h][0] = vgC[_h][0]; vgN[_h][1] = vgC[_h][1]; } } }
        for (int t = 0; t < nt; t += 2) {
            const bool last = (t == nt - 2);
            const char* a1 = cA + (size_t)(t + 1) * kstep;
            const char* a2 = last ? nA : cA + (size_t)(t + 2) * kstep; const char* b2 = last ? nB : cB + (size_t)(t + 2) * kstep;
            const char* a3 = a2 + kstep; const char* b3 = b2 + kstep;
            PG8_LDB(0, 0, 0); PG8_LDB(1, 0, 1); PG8_SCHED; PG8_LDA(0, 0); PG8_STAGE_A(PG8_SA(1, 1), a1, 1, false);
            PG8_WAIT_V(8); PG8_WAIT_L(0); PG8_BAR; PG8_MMA(0, 0); PG8_MMA(0, 1); PG8_BAR; PG8_SCHED;
            PG8_LDA(0, 1); PG8_STAGE_B(PG8_SB(0, 0), b2); PG8_STAGE_B(PG8_SB(0, 1), b2 + hstepB); PG8_STAGE_A(PG8_SA(0, 0), a2, 0, last);
            PG8_WAIT_V(8); PG8_WAIT_L(0); PG8_BAR; PG8_MMA(1, 0); PG8_MMA(1, 1); PG8_BAR; PG8_SCHED;
            PG8_LDB(0, 1, 0); PG8_LDB(1, 1, 1); PG8_SCHED; PG8_LDA(1, 0); PG8_STAGE_A(PG8_SA(0, 1), a2, 1, last);
            PG8_WAIT_V(8); PG8_WAIT_L(0); PG8_BAR; PG8_MMA(0, 0); PG8_MMA(0, 1); PG8_BAR; PG8_SCHED;
            PG8_LDA(1, 1); PG8_STAGE_B(PG8_SB(1, 0), b3); PG8_STAGE_B(PG8_SB(1, 1), b3 + hstepB); PG8_STAGE_A(PG8_SA(1, 0), a3, 0, last);
            PG8_WAIT_V(8); PG8_WAIT_L(0); PG8_BAR; PG8_MMA(1, 0); PG8_MMA(1, 1); PG8_BAR; PG8_SCHED;
        }
        if constexpr (ALIGN_EPI) { if (wr == 0) PG8_BAR; }
        if constexpr (FP8) asm volatile("s_nop 15\n\ts_nop 15" ::: "memory");
        if constexpr (I8) {
#pragma unroll
            for (int a = 0; a < 2; ++a)
#pragma unroll
                for (int b = 0; b < 2; ++b)
#pragma unroll
                    for (int m = 0; m < 4; ++m)
#pragma unroll
                        for (int n = 0; n < 2; ++n) acc[a][b][m][n] = __builtin_convertvector(__builtin_bit_cast(i32x4, acc[a][b][m][n]), f32x4); }
        E(acc, cur, wr, wc, fr, fq);
        if (!has_next) break;
#pragma unroll
        for (int a = 0; a < 2; ++a)
#pragma unroll
            for (int b = 0; b < 2; ++b)
#pragma unroll
                for (int m = 0; m < 4; ++m)
#pragma unroll
                    for (int n = 0; n < 2; ++n) acc[a][b][m][n] = (f32x4){0.f, 0.f, 0.f, 0.f};
        cur = nxt; cA = nA; cB = nB; ++ui;
        if constexpr (GATHER) {
#pragma unroll
            for (int _h = 0; _h < 2; ++_h) { vgC[_h][0] = vgN[_h][0]; vgC[_h][1] = vgN[_h][1]; } }
        if constexpr (ALIGN_EPI) { if (wr == 1) PG8_BAR; }
    }
    PG8_WAIT_V(0);
    if constexpr (!ALIGN_EPI) { if (wr == 0) PG8_BAR; }
    PG8_BAR;
#undef PG8_SA
#undef PG8_SB
#undef PG8_GLDS
#undef PG8_STAGE_A
#undef PG8_STAGE_B
#undef PG8_LDA
#undef PG8_LDB
#undef PG8_MMA
#undef PG8_WAIT_V
#undef PG8_WAIT_L
#undef PG8_BAR
#undef PG8_SCHED
#undef PG8_VG
}

typedef f32x4 AccT[2][2][4][2];
struct EpiProj {
    static constexpr bool PERM = true;
    bf16_t* PROJ; bf16_t* CQ; bf16_t* CKV; bf16_t* KR; const float* rope; float* ssq2;
    __device__ __forceinline__ void operator()(const AccT& acc, const Unit& u, int wr, int wc, int fr, int fq) const {
        const int row0 = u.pm * BM + wr * 64 + fr;
        if (ssq2 && u.pn >= 12 && u.pn < 15) {
#pragma unroll
            for (int ai = 0; ai < 2; ++ai)
#pragma unroll
                for (int m = 0; m < 4; ++m) { float q = 0.f;
#pragma unroll
                    for (int bj = 0; bj < 2; ++bj)
#pragma unroll
                        for (int n = 0; n < 2; ++n) { const f32x4 v = acc[ai][bj][m][n]; q += (v[0] * v[0] + v[1] * v[1]) + (v[2] * v[2] + v[3] * v[3]); }
                    q += __shfl_xor(q, 16); q += __shfl_xor(q, 32);
                    if (fq == 0) ssq2[(size_t)(row0 + ai * HALF + m * 16) * 12 + (u.pn - 12) * 4 + wc] = q; } }
        if (u.pn < 15) {
            bf16_t* base; int ld, colt;
            if (u.pn < 12) { base = PROJ; ld = 3072; colt = u.pn * 256; } else if (u.pn < 14) { base = CQ; ld = 512; colt = (u.pn - 12) * 256; } else { base = CKV; ld = 256; colt = 0; }
            const int col0 = colt + wc * 32 + 8 * fq;
#pragma unroll
            for (int ai = 0; ai < 2; ++ai)
#pragma unroll
                for (int m = 0; m < 4; ++m) { bf16_t* rowp = base + (size_t)(row0 + ai * HALF + m * 16) * ld + col0;
#pragma unroll
                    for (int bj = 0; bj < 2; ++bj) *(u32x4*)(rowp + bj * HALF) = pack8(acc[ai][bj][m][0], acc[ai][bj][m][1]); }
        } else if (wc < 2) {
            const int c0 = wc * 32 + 8 * fq, i0 = c0 >> 1;
#pragma unroll
            for (int ai = 0; ai < 2; ++ai)
#pragma unroll
                for (int m = 0; m < 4; ++m) { const int row = row0 + ai * HALF + m * 16; const float* rp = rope + (size_t)(row & (SEQ - 1)) * 64 + i0;
                    const f32x4 cs = *(const f32x4*)rp, sn = *(const f32x4*)(rp + 32); const f32x4 v0 = acc[ai][0][m][0], v1 = acc[ai][0][m][1];
                    f32x4 o0, o1;
                    o0[0] = v0[0] * cs[0] - v0[1] * sn[0]; o0[1] = v0[0] * sn[0] + v0[1] * cs[0]; o0[2] = v0[2] * cs[1] - v0[3] * sn[1]; o0[3] = v0[2] * sn[1] + v0[3] * cs[1];
                    o1[0] = v1[0] * cs[2] - v1[1] * sn[2]; o1[1] = v1[0] * sn[2] + v1[1] * cs[2]; o1[2] = v1[2] * cs[3] - v1[3] * sn[3]; o1[3] = v1[2] * sn[3] + v1[3] * cs[3];
                    *(u32x4*)(KR + (size_t)row * 64 + c0) = pack8(o0, o1); }
        }
    }
};
struct EpiQ {
    static constexpr bool PERM = true;
    bf16_t* Q; const float* rope; const float* ssq2;
    __device__ __forceinline__ void operator()(const AccT& acc, const Unit& u, int wr, int wc, int fr, int fq) const {
        const int row0 = u.pm * BM + wr * 64 + fr;
#pragma unroll
        for (int ai = 0; ai < 2; ++ai)
#pragma unroll
            for (int m = 0; m < 4; ++m) { const int row = row0 + ai * HALF + m * 16; float sc = QSCALE;
                if (ssq2) { const float* p = ssq2 + (size_t)row * 12; const f32x4 a = *(const f32x4*)p, b = *(const f32x4*)(p + 4);
                    sc = QSCALE / sqrtf((((a[0] + a[1]) + (a[2] + a[3])) + ((b[0] + b[1]) + (b[2] + b[3]))) * (1.f / QLORA) + EPS); }
#pragma unroll
                for (int bj = 0; bj < 2; ++bj) { const int c = u.pn * 256 + bj * HALF + wc * 32 + 8 * fq, d = c % QKD; const bool isr = d >= 128; const int i0 = isr ? ((d - 128) >> 1) : 0;
                    f32x4 v0 = acc[ai][bj][m][0] * sc, v1 = acc[ai][bj][m][1] * sc;
                    if (isr) { const float* rp = rope + (size_t)(row & (SEQ - 1)) * 64 + i0; const f32x4 cs = *(const f32x4*)rp, sn = *(const f32x4*)(rp + 32); f32x4 o0, o1;
                        o0[0] = v0[0] * cs[0] - v0[1] * sn[0]; o0[1] = v0[0] * sn[0] + v0[1] * cs[0]; o0[2] = v0[2] * cs[1] - v0[3] * sn[1]; o0[3] = v0[2] * sn[1] + v0[3] * cs[1];
                        o1[0] = v1[0] * cs[2] - v1[1] * sn[2]; o1[1] = v1[0] * sn[2] + v1[1] * cs[2]; o1[2] = v1[2] * cs[3] - v1[3] * sn[3]; o1[3] = v1[2] * sn[3] + v1[3] * cs[3]; v0 = o0; v1 = o1; }
                    *(u32x4*)(Q + (size_t)row * 1536 + c) = pack8(v0, v1); }
                if (m & 1) asm volatile("" ::: "memory"); }
    }
};
struct EpiKV {
    static constexpr bool PERM = true;
    bf16_t* KN; bf16_t* V; const float* ssq2;
    __device__ __forceinline__ void operator()(const AccT& acc, const Unit& u, int wr, int wc, int fr, int fq) const {
        const int row0 = u.pm * BM + wr * 64 + fr, col0 = u.pn * 128 + wc * 32 + 8 * fq;
#pragma unroll
        for (int ai = 0; ai < 2; ++ai)
#pragma unroll
            for (int m = 0; m < 4; ++m) { const int row = row0 + ai * HALF + m * 16; const size_t off = (size_t)row * 1024 + col0; float rs = 1.f;
                if (ssq2) { const f32x4 a = *(const f32x4*)(ssq2 + (size_t)row * 12 + 8); rs = 1.0f / sqrtf(((a[0] + a[1]) + (a[2] + a[3])) * (1.f / KVLORA) + EPS); }
                *(u32x4*)(KN + off) = pack8(acc[ai][0][m][0] * rs, acc[ai][0][m][1] * rs); *(u32x4*)(V + off) = pack8(acc[ai][1][m][0] * rs, acc[ai][1][m][1] * rs); }
    }
};
template <bool SSQ> struct EpiRes {
    static constexpr bool PERM = false;
    const float* base; float* out; const float* scale; float* ssq;
    __device__ __forceinline__ void operator()(const AccT& acc, const Unit& u, int wr, int wc, int fr, int fq) const {
        const int col0 = u.pn * BM + wc * 32 + 4 * fq; f32x4 sv[2][2];
#pragma unroll
        for (int bj = 0; bj < 2; ++bj)
#pragma unroll
            for (int n = 0; n < 2; ++n) sv[bj][n] = scale ? *(const f32x4*)(scale + col0 + bj * HALF + n * 16) : (f32x4){1.f, 1.f, 1.f, 1.f};
#pragma unroll
        for (int ai = 0; ai < 2; ++ai)
#pragma unroll
            for (int m = 0; m < 4; ++m) { const int row = u.pm * BM + ai * HALF + wr * 64 + m * 16 + fr; const size_t off = (size_t)row * DM + col0; float q = 0.f;
#pragma unroll
                for (int bj = 0; bj < 2; ++bj)
#pragma unroll
                    for (int n = 0; n < 2; ++n) { const f32x4 bs = *(const f32x4*)(base + off + bj * HALF + n * 16); const f32x4 o = bs + acc[ai][bj][m][n] * sv[bj][n]; *(f32x4*)(out + off + bj * HALF + n * 16) = o;
                        if constexpr (SSQ) q += (o[0] * o[0] + o[1] * o[1]) + (o[2] * o[2] + o[3] * o[3]); }
                if constexpr (SSQ) { q += __shfl_xor(q, 16); q += __shfl_xor(q, 32); if (fq == 0) ssq[(size_t)row * 32 + u.pn * 4 + wc] = q; }
                if (m & 1) asm volatile("" ::: "memory"); }
    }
};
template <bool SSQ, bool BASE_F32> struct EpiResB {
    static constexpr bool PERM = true;
    const void* base; bf16_t* out; const float* scale; float* ssq;
    __device__ __forceinline__ void operator()(const AccT& acc, const Unit& u, int wr, int wc, int fr, int fq) const {
        const int col0 = u.pn * BM + wc * 32 + 8 * fq; f32x4 sv[2][2];
#pragma unroll
        for (int bj = 0; bj < 2; ++bj)
#pragma unroll
            for (int n = 0; n < 2; ++n) sv[bj][n] = scale ? *(const f32x4*)(scale + col0 + bj * HALF + n * 4) : (f32x4){1.f, 1.f, 1.f, 1.f};
#pragma unroll
        for (int ai = 0; ai < 2; ++ai)
#pragma unroll
            for (int m = 0; m < 4; ++m) { const int row = u.pm * BM + ai * HALF + wr * 64 + m * 16 + fr; const size_t off = (size_t)row * DM + col0; float q = 0.f;
#pragma unroll
                for (int bj = 0; bj < 2; ++bj) { f32x4 b0, b1;
                    if constexpr (BASE_F32) { b0 = *(const f32x4*)((const float*)base + off + bj * HALF); b1 = *(const f32x4*)((const float*)base + off + bj * HALF + 4); }
                    else { const u32x4 w = *(const u32x4*)((const bf16_t*)base + off + bj * HALF); b0 = (f32x4){bflo(w.x), bfhi(w.x), bflo(w.y), bfhi(w.y)}; b1 = (f32x4){bflo(w.z), bfhi(w.z), bflo(w.w), bfhi(w.w)}; }
                    const f32x4 o0 = b0 + acc[ai][bj][m][0] * sv[bj][0], o1 = b1 + acc[ai][bj][m][1] * sv[bj][1];
                    *(u32x4*)(out + off + bj * HALF) = pack8(o0, o1);
                    if constexpr (SSQ) q += ((o0[0] * o0[0] + o0[1] * o0[1]) + (o0[2] * o0[2] + o0[3] * o0[3])) + ((o1[0] * o1[0] + o1[1] * o1[1]) + (o1[2] * o1[2] + o1[3] * o1[3])); }
                if constexpr (SSQ) { q += __shfl_xor(q, 16); q += __shfl_xor(q, 32); if (fq == 0) ssq[(size_t)row * 32 + u.pn * 4 + wc] = q; }
                if (m & 1) asm volatile("" ::: "memory"); }
    }
};
template <bool OUT8> struct EpiSwiGLU {
    static constexpr bool PERM = true;
    bf16_t* H; int ldh; const float* rowgate; const float* prerow; float pre; const float* precol;
    __device__ __forceinline__ void operator()(const AccT& acc, const Unit& u, int wr, int wc, int fr, int fq) const {
        const int row0 = u.pm * BM + wr * 64 + fr, col0 = u.pn * 128 + wc * 32 + 8 * fq;
        f32x4 cg[2], cu[2];
#pragma unroll
        for (int n = 0; n < 2; ++n) { cg[n] = precol ? *(const f32x4*)(precol + u.pn * 256 + wc * 32 + 8 * fq + 4 * n) : (f32x4){1.f, 1.f, 1.f, 1.f}; cu[n] = precol ? *(const f32x4*)(precol + u.pn * 256 + 128 + wc * 32 + 8 * fq + 4 * n) : (f32x4){1.f, 1.f, 1.f, 1.f}; }
#pragma unroll
        for (int ai = 0; ai < 2; ++ai)
#pragma unroll
            for (int m = 0; m < 4; ++m) { const int row = row0 + ai * HALF + m * 16; const float rg = rowgate ? rowgate[row] : 1.f; const float ps = prerow ? prerow[row] * pre : 1.f; f32x4 o[2];
#pragma unroll
                for (int n = 0; n < 2; ++n)
#pragma unroll
                    for (int j = 0; j < 4; ++j) { const float gt = acc[ai][0][m][n][j] * ps * cg[n][j], up = acc[ai][1][m][n][j] * ps * cu[n][j];
                        const float sg = gt * __builtin_amdgcn_rcpf(1.f + __builtin_amdgcn_exp2f(-1.4426950408889634f * gt)); o[n][j] = sg * up * rg; }
                if constexpr (OUT8) { u32x2 w; int t;
                    t = __builtin_amdgcn_cvt_pk_fp8_f32(o[0][0] * 4.f, o[0][1] * 4.f, 0, false); t = __builtin_amdgcn_cvt_pk_fp8_f32(o[0][2] * 4.f, o[0][3] * 4.f, t, true); w.x = (unsigned)t;
                    t = __builtin_amdgcn_cvt_pk_fp8_f32(o[1][0] * 4.f, o[1][1] * 4.f, 0, false); t = __builtin_amdgcn_cvt_pk_fp8_f32(o[1][2] * 4.f, o[1][3] * 4.f, t, true); w.y = (unsigned)t;
                    *(u32x2*)((unsigned char*)H + (size_t)row * ldh + col0) = w; }
                else *(u32x4*)(H + (size_t)row * ldh + col0) = pack8(o[0], o[1]); }
    }
};
struct EpiScatter {
    static constexpr bool PERM = true;
    bf16_t* Y; const int* dest;
    __device__ __forceinline__ void operator()(const AccT& acc, const Unit& u, int wr, int wc, int fr, int fq) const {
        const int row0 = u.pm * BM + wr * 64 + fr, col0 = u.pn * 256 + wc * 32 + 8 * fq;
#pragma unroll
        for (int ai = 0; ai < 2; ++ai)
#pragma unroll
            for (int m = 0; m < 4; ++m) { const int d = dest[row0 + ai * HALF + m * 16];
                if (d >= 0) { bf16_t* rowp = Y + (size_t)d * DM + col0;
#pragma unroll
                    for (int bj = 0; bj < 2; ++bj) *(u32x4*)(rowp + bj * HALF) = pack8(acc[ai][bj][m][0], acc[ai][bj][m][1]); } }
    }
};
}

namespace att {
constexpr int KSTR = 400, SHM_K = 64 * KSTR, SHM_V = 16384;
constexpr int OFF_V = 0, OFF_K = 2 * SHM_V, OFF_WS = OFF_K + 2 * SHM_K, ATT_LDS = OFF_WS + NWAVES * 64 * 4;
static_assert(ATT_LDS <= RING_BYTES, "attention LDS");
#define SBAR() __builtin_amdgcn_sched_barrier(0)
__device__ __forceinline__ int v_st(int k, int c) { const int kk = (k & ~0xC) | ((k & 4) << 1) | ((k & 8) >> 1); return ((kk >> 3) * 4 + (c >> 5)) * 512 + ((kk & 7) * 32 + (c & 31)) * 2; }
__device__ __forceinline__ int v_rd_base(int lane) { return ((lane & 3) << 3) | (((lane >> 2) & 3) << 6) | (((lane >> 4) & 1) << 5) | (((lane >> 5) & 1) << 8); }
__device__ __forceinline__ int crow(int r, int hi) { return (r & 3) + 8 * (r >> 2) + 4 * hi; }
__device__ __forceinline__ void mask_tile(f32x16& p0, f32x16& p1, int dq) {
    const float NEG = -__builtin_inff();
#pragma unroll
    for (int r = 0; r < 16; ++r) { const int c = (r & 3) + 8 * (r >> 2); if (c > dq) p0[r] = NEG; if (c + 32 > dq) p1[r] = NEG; }
}
__device__ __forceinline__ void partialSM(f32x16& p0, f32x16& p1, float& m_reg, float& mn, float& alpha) {
    float pmax = p0[0];
#pragma unroll
    for (int r = 1; r < 16; ++r) pmax = fmaxf(pmax, p0[r]);
#pragma unroll
    for (int r = 0; r < 16; ++r) pmax = fmaxf(pmax, p1[r]);
    { auto rr = __builtin_amdgcn_permlane32_swap(__float_as_uint(pmax), __float_as_uint(pmax), false, false); pmax = fmaxf(__uint_as_float(rr[0]), __uint_as_float(rr[1])); }
    if (__builtin_expect(__all((pmax - m_reg) <= 8.f), 1)) { mn = m_reg; alpha = 1.f; }
    else { mn = fmaxf(m_reg, pmax); alpha = __builtin_amdgcn_exp2f(m_reg - mn); m_reg = mn; }
#pragma unroll
    for (int r = 0; r < 16; ++r) p0[r] = __builtin_amdgcn_exp2f(p0[r] - mn);
}
__device__ __forceinline__ void finishSM(f32x16& p0, f32x16& p1, float mn, float alpha, float& l_reg, bf16x8& pa0, bf16x8& pa1, bf16x8& pa2, bf16x8& pa3) {
#pragma unroll
    for (int r = 0; r < 16; ++r) p1[r] = __builtin_amdgcn_exp2f(p1[r] - mn);
    float ps = 0;
#pragma unroll
    for (int r = 0; r < 16; ++r) ps += p0[r];
#pragma unroll
    for (int r = 0; r < 16; ++r) ps += p1[r];
    { auto rr = __builtin_amdgcn_permlane32_swap(__float_as_uint(ps), __float_as_uint(ps), false, false); ps = __uint_as_float(rr[0]) + __uint_as_float(rr[1]); }
    l_reg = l_reg * alpha + ps;
#define PK4(P, B_, OUT) do { unsigned a0 = cvt_pk_bf16(P[B_+0], P[B_+1]), a1 = cvt_pk_bf16(P[B_+2], P[B_+3]); \
        unsigned b0 = cvt_pk_bf16(P[B_+4], P[B_+5]), b1 = cvt_pk_bf16(P[B_+6], P[B_+7]); \
        auto r0 = __builtin_amdgcn_permlane32_swap(a0, b0, false, false); auto r1 = __builtin_amdgcn_permlane32_swap(a1, b1, false, false); \
        u32x4 w = {r0[0], r1[0], r0[1], r1[1]}; OUT = *reinterpret_cast<bf16x8*>(&w); } while (0)
    PK4(p0, 0, pa0); PK4(p0, 8, pa1); PK4(p1, 0, pa2); PK4(p1, 8, pa3);
#undef PK4
}
__device__ __forceinline__ void qkt(f32x16& p0, f32x16& p1, const char* kb, const bf16x8* qr) {
    p0 = f32x16{}; p1 = f32x16{};
#pragma unroll
    for (int g = 0; g < 4; ++g) {
        bf16x8 b0[3], b1[3];
#pragma unroll
        for (int j = 0; j < 3; ++j) { b0[j] = *reinterpret_cast<const bf16x8*>(kb + (g * 3 + j) * 32); b1[j] = *reinterpret_cast<const bf16x8*>(kb + (g * 3 + j) * 32 + 32 * KSTR); }
#pragma unroll
        for (int j = 0; j < 3; ++j) { p0 = __builtin_amdgcn_mfma_f32_32x32x16_bf16(b0[j], qr[g * 3 + j], p0, 0, 0, 0); p1 = __builtin_amdgcn_mfma_f32_32x32x16_bf16(b1[j], qr[g * 3 + j], p1, 0, 0, 0); }
        SBAR();
    }
}
__device__ __forceinline__ void pv_tile(f32x16* o, int vb, bf16x8 pa0, bf16x8 pa1, bf16x8 pa2, bf16x8 pa3) {
#define TRRD(dst, off) asm volatile("ds_read_b64_tr_b16 %0, %1 offset:%2" : "=&v"(dst) : "v"(vb), "i"(off) : "memory")
#define PV_D0(d0) do { s16x4 l0, l1, l2, l3, h0, h1, h2, h3; constexpr int b_ = (d0) * 512; \
        TRRD(l0, b_); TRRD(h0, b_ + 2048); TRRD(l1, b_ + 4096); TRRD(h1, b_ + 6144); TRRD(l2, b_ + 8192); TRRD(h2, b_ + 10240); TRRD(l3, b_ + 12288); TRRD(h3, b_ + 14336); \
        asm volatile("s_waitcnt lgkmcnt(0)" ::: "memory"); SBAR(); \
        o[d0] = __builtin_amdgcn_mfma_f32_32x32x16_bf16(pa0, (bf16x8){l0[0], l0[1], l0[2], l0[3], h0[0], h0[1], h0[2], h0[3]}, o[d0], 0, 0, 0); \
        o[d0] = __builtin_amdgcn_mfma_f32_32x32x16_bf16(pa1, (bf16x8){l1[0], l1[1], l1[2], l1[3], h1[0], h1[1], h1[2], h1[3]}, o[d0], 0, 0, 0); \
        o[d0] = __builtin_amdgcn_mfma_f32_32x32x16_bf16(pa2, (bf16x8){l2[0], l2[1], l2[2], l2[3], h2[0], h2[1], h2[2], h2[3]}, o[d0], 0, 0, 0); \
        o[d0] = __builtin_amdgcn_mfma_f32_32x32x16_bf16(pa3, (bf16x8){l3[0], l3[1], l3[2], l3[3], h3[0], h3[1], h3[2], h3[3]}, o[d0], 0, 0, 0); } while (0)
    PV_D0(0); PV_D0(1); PV_D0(2); PV_D0(3);
#undef PV_D0
#undef TRRD
}
__device__ __forceinline__ void attn_unit(int b, int h, int qb, const bf16_t* Q, const bf16_t* KN, const bf16_t* KR, const bf16_t* V, bf16_t* Y, char* lds, const int tid) {
    const int wid = __builtin_amdgcn_readfirstlane(tid >> 6), lane = tid & 63, r32 = lane & 31, hi = lane >> 5;
    const size_t rowbase = (size_t)b * SEQ; const int q0 = qb * 256, qlo = q0 + wid * 32;
    bf16x8 qr[12];
    { const bf16_t* qp = Q + (rowbase + qlo + r32) * 1536 + h * QKD + hi * 8;
#pragma unroll
      for (int d0 = 0; d0 < 12; ++d0) qr[d0] = *reinterpret_cast<const bf16x8*>(qp + d0 * 16); }
    const int NT = 4 * (qb + 1);
    char* V_lds = lds + OFF_V; char* K_lds = lds + OFF_K;
    float* ws = (float*)(lds + OFF_WS) + wid * 64; float* li_l = ws; float* al_l = ws + 32;
    const char* kbase = (const char*)(KN + rowbase * 1024 + h * 128); const char* rbase = (const char*)(KR + rowbase * 64); const char* vbase = (const char*)(V + rowbase * 1024 + h * 128);
    const char* ksrc[4]; unsigned kstr[4]; const char* vsrc[2];
#pragma unroll
    for (int i = 0; i < 4; ++i) { const int o_ = 1024 * (wid + 8 * i) + 16 * lane, row = o_ / KSTR, cb = o_ - row * KSTR;
        if (cb < 256) { ksrc[i] = kbase + row * 2048 + cb; kstr[i] = 131072u; } else if (cb < 384) { ksrc[i] = rbase + row * 128 + (cb - 256); kstr[i] = 8192u; } else { ksrc[i] = kbase + row * 2048; kstr[i] = 131072u; } }
#pragma unroll
    for (int i = 0; i < 2; ++i) { const int o_ = 1024 * (wid + 8 * i) + 16 * lane, st_ = o_ >> 9, kk = (st_ >> 2) * 8 + ((o_ >> 6) & 7), k = (kk & ~0xC) | ((kk & 4) << 1) | ((kk & 8) >> 1), c = (st_ & 3) * 32 + ((o_ & 63) >> 1);
        vsrc[i] = vbase + k * 2048 + c * 2; }
    LAS unsigned char* lds3 = (LAS unsigned char*)lds;
#define DMA_TILE(bf) do { _Pragma("unroll") for (int i_ = 0; i_ < 4; ++i_) if (i_ < 3 || wid == 0) { \
            __builtin_amdgcn_global_load_lds((const unsigned*)ksrc[i_], (LAS unsigned*)(lds3 + OFF_K + (bf) * SHM_K + (wid + 8 * i_) * 1024), 16, 0, 0); ksrc[i_] += kstr[i_]; } \
        _Pragma("unroll") for (int i_ = 0; i_ < 2; ++i_) { __builtin_amdgcn_global_load_lds((const unsigned*)vsrc[i_], (LAS unsigned*)(lds3 + OFF_V + (bf) * SHM_V + (wid + 8 * i_) * 1024), 16, 0, 0); vsrc[i_] += 131072; } } while (0)
    float m_reg = -1e30f, l_reg = 0.f; f32x16 o[4] = {};
    const int vb0 = (int)(uintptr_t)V_lds + v_rd_base(lane);
    const int qrow = qlo + r32;
    DMA_TILE(0); VM_WAIT(); __syncthreads();
    for (int t = 0; t < NT; ++t) {
        const int buf = t & 1, kb = t * 64;
        if (t + 1 < NT) DMA_TILE(buf ^ 1);
        SBAR();
        if (kb <= qlo + 31) {
            f32x16 p0, p1; float mn, al; bf16x8 pa0, pa1, pa2, pa3;
            qkt(p0, p1, K_lds + buf * SHM_K + r32 * KSTR + hi * 16, qr);
            if (kb + 63 > qlo) mask_tile(p0, p1, qrow - kb - 4 * hi);
            partialSM(p0, p1, m_reg, mn, al);
            finishSM(p0, p1, mn, al, l_reg, pa0, pa1, pa2, pa3);
            if (__any(al < 1.f)) { if (hi == 0) al_l[r32] = al; LDS_WAIT();
#pragma unroll
                for (int d_ = 0; d_ < 4; ++d_)
#pragma unroll
                    for (int r = 0; r < 16; ++r) o[d_][r] *= al_l[crow(r, hi)]; }
            SBAR();
            pv_tile(o, vb0 + buf * SHM_V, pa0, pa1, pa2, pa3);
        }
        SBAR();
        VM_WAIT();
        __syncthreads();
    }
    if (hi == 0) li_l[r32] = l_reg; LDS_WAIT();
    bf16_t* Ow = Y + (rowbase + qlo) * DM + 1024 + h * 128;
#pragma unroll
    for (int r = 0; r < 16; ++r) { const int orow = crow(r, hi); const float rl = __builtin_amdgcn_rcpf(li_l[orow]);
#pragma unroll
        for (int d0 = 0; d0 < 4; ++d0) { const float v = o[d0][r] * rl; const float vn = __shfl_xor(v, 1);
            if ((r32 & 1) == 0) *(unsigned*)(Ow + (size_t)orow * DM + d0 * 32 + r32) = cvt_pk_bf16(v, vn); } }
    __syncthreads();
#undef DMA_TILE
}
#undef SBAR
}

#define XB_TMO      128
#define XB_XCNT(j)  (256  + 64 * (j))
#define XB_XSUB(j)  (1280 + 64 * (j))
#define XB_XGEN(j)  (2304 + 64 * (j))
#define XB_TOP      3328
#define XB_TOPGEN   3392
#define XCD_BAR_WORDS 3456
#define XB_SPIN_CAP (1u << 18)
__device__ __forceinline__ unsigned xb_ld(unsigned* p)              { return __hip_atomic_load(p, __ATOMIC_RELAXED, __HIP_MEMORY_SCOPE_AGENT); }
__device__ __forceinline__ unsigned xb_add(unsigned* p, unsigned v) { return __hip_atomic_fetch_add(p, v, __ATOMIC_RELAXED, __HIP_MEMORY_SCOPE_AGENT); }
__device__ __forceinline__ unsigned xb_xcc_id() { return (unsigned)__builtin_amdgcn_s_getreg((3 << 11) | 20) & 0xFu; }
#define XB_SPIN(cond, bar) do { unsigned _sp = 0; while (cond) { __builtin_amdgcn_s_sleep(1); \
    if ((++_sp & 255u) == 0u) { if (xb_ld(&(bar)[XB_TMO])) break; if (_sp > XB_SPIN_CAP) { atomicAdd(&(bar)[XB_TMO], 1u); break; } } } } while (0)
struct XcdBarrier { unsigned* bar; unsigned x; volatile LAS unsigned* st; };
__device__ __forceinline__ XcdBarrier xcd_barrier_post(unsigned* bar, volatile LAS unsigned* st) {
    XcdBarrier b; b.bar = bar; b.x = xb_xcc_id(); b.st = st;
    if (threadIdx.x == 0) (void)xb_add(&bar[XB_XCNT(b.x)], 1u);
    return b;
}
__device__ __forceinline__ void xcd_barrier_complete(unsigned* bar, unsigned x, unsigned& nloc, unsigned& nx) {
    const unsigned G = gridDim.x * gridDim.y * gridDim.z;
    unsigned sum, cnt, mine, sp = 0u;
    for (;;) {
        sum = 0u; cnt = 0u; mine = 0u;
#pragma unroll
        for (unsigned j = 0; j < 16; ++j) { const unsigned c = xb_ld(&bar[XB_XCNT(j)]); sum += c; cnt += (c > 0u) ? 1u : 0u; mine = (j == x) ? c : mine; }
        if (sum == G) break;
        __builtin_amdgcn_s_sleep(1);
        if ((++sp & 255u) == 0u) { if (xb_ld(&bar[XB_TMO])) break; if (sp > XB_SPIN_CAP) { atomicAdd(&bar[XB_TMO], 1u); break; } }
    }
    nloc = mine > 0u ? mine : 1u; nx = cnt > 0u ? cnt : 1u;
}
__device__ __forceinline__ void xcd_barrier(const XcdBarrier& b) {
    asm volatile("s_waitcnt vmcnt(0)" ::: "memory");
    __syncthreads();
    if (threadIdx.x == 0) {
        unsigned* bar = b.bar;
        __builtin_amdgcn_s_waitcnt(0);
        unsigned nloc = b.st[0], nx = b.st[1];
        if (nloc == 0u) { xcd_barrier_complete(bar, b.x, nloc, nx); b.st[0] = nloc; b.st[1] = nx; }
        const unsigned old = xb_add(&bar[XB_XSUB(b.x)], 1u);
        const unsigned gen = old / nloc;
        if (old + 1u == (gen + 1u) * nloc) {
            __builtin_amdgcn_fence(__ATOMIC_RELEASE, "agent");
            asm volatile("s_waitcnt vmcnt(0)" ::: "memory");
            const unsigned og = xb_add(&bar[XB_TOP], 1u);
            const unsigned tg = og / nx;
            if (og + 1u == (tg + 1u) * nx) xb_add(&bar[XB_TOPGEN], 1u);
            else XB_SPIN(xb_ld(&bar[XB_TOPGEN]) == tg, bar);
            __builtin_amdgcn_fence(__ATOMIC_ACQUIRE, "agent");
            xb_add(&bar[XB_XGEN(b.x)], 1u);
            asm volatile("s_waitcnt vmcnt(0)" ::: "memory");
        } else {
            XB_SPIN(xb_ld(&bar[XB_XGEN(b.x)]) == gen, bar);
            __builtin_amdgcn_fence(__ATOMIC_ACQUIRE, "agent");
            asm volatile("s_waitcnt vmcnt(0)" ::: "memory");
        }
    }
    __syncthreads();
}

struct Args {
    const float* in[22]; float* out; unsigned char* ws; float inv_freq[32]; int ph_lo, ph_hi;
};
struct Frame {
    LAS unsigned char* lds; int wave, G, blk, vcu;
};
#if FOLD_QKV_NORM
enum { PH_PRO = 0, PH_PROJ, PH_QKV, PH_ATTN, PH_WOUT, PH_NORM1, PH_FFNUP, PH_FFNDN, PH_POOL, PH_POOLG, PH_ROUTE, PH_SORT, PH_MOEUP, PH_MOEDN, PH_FINAL, NPH };
#else
enum { PH_PRO = 0, PH_PROJ, PH_CONV, PH_QKV, PH_ATTN, PH_WOUT, PH_NORM1, PH_FFNUP, PH_FFNDN, PH_POOL, PH_POOLG, PH_ROUTE, PH_SORT, PH_MOEUP, PH_MOEDN, PH_FINAL, NPH };
#endif
enum { I_X = 0, I_NMIX0, I_WIN, I_CONVW, I_QNORM, I_WUQ, I_KVNORM, I_WUKV, I_WOUT, I_NFFN0, I_FG, I_FU, I_FD, I_NMIX1, I_POOLW, I_POOLS, I_NFFN1, I_ROUTER, I_MG, I_MU, I_MD, I_FNORM };

__device__ __forceinline__ void sincos_d(double a, double& sn, double& cs) {
    const double k = rint(a * 0.63661977236758134308); const double r = (a - k * 1.57079632679489655800) - k * 6.12323399573676603587e-17; const double r2 = r * r;
    double s = -1.0 / 1307674368000.0; s = s * r2 + 1.0 / 6227020800.0; s = s * r2 - 1.0 / 39916800.0; s = s * r2 + 1.0 / 362880.0; s = s * r2 - 1.0 / 5040.0; s = s * r2 + 1.0 / 120.0; s = s * r2 - 1.0 / 6.0; s = s * r2 * r + r;
    double c = 1.0 / 20922789888000.0; c = c * r2 - 1.0 / 87178291200.0; c = c * r2 + 1.0 / 479001600.0; c = c * r2 - 1.0 / 3628800.0; c = c * r2 + 1.0 / 40320.0; c = c * r2 - 1.0 / 720.0; c = c * r2 + 1.0 / 24.0; c = c * r2 - 0.5; c = c * r2 + 1.0;
    const int q = (int)((long long)k & 3);
    sn = (q == 0) ? s : (q == 1) ? c : (q == 2) ? -s : -c; cs = (q == 0) ? c : (q == 1) ? -s : (q == 2) ? -c : s;
}
__device__ __forceinline__ int ropeperm(int j) { return j < 32 ? 2 * j : 2 * (j - 32) + 1; }
__device__ __forceinline__ int destrow(int mode, int n) {
    if (mode == 1) return n < 3840 ? n : 3840 + ropeperm(n - 3840);
    if (mode == 2) { const int h = n / QKD, d = n - h * QKD; return d < 128 ? n : h * QKD + 128 + ropeperm(d - 128); }
    if (mode == 3) return (n >> 7) * 256 + (n & 127);
    return n;
}
__device__ __forceinline__ void p0_transpose_item(const float* W, int K, int N, bf16_t* WT, int mode, int row_off, LAS float* scr, int item, int lane, const float* kscale = nullptr) {
    const int nblk = N / 32, kb = item / nblk, nb = item % nblk, k0 = 64 * kb, n0 = 32 * nb;
    float t_[32];
#pragma unroll
    for (int i = 0; i < 32; ++i) { const int kk = 2 * i + (lane >> 5); t_[i] = __builtin_nontemporal_load(W + (size_t)(k0 + kk) * N + n0 + (lane & 31)); }
#pragma unroll
    for (int i = 0; i < 32; ++i) { const int kk = 2 * i + (lane >> 5); scr[kk * 33 + (lane & 31)] = kscale ? t_[i] * kscale[k0 + kk] : t_[i]; }
    LDS_WAIT(); asm volatile("" ::: "memory");
    const int c = lane & 7;
#pragma unroll
    for (int j = 0; j < 4; ++j) { const int n = (lane >> 3) + 8 * j; const LAS float* s = scr + (8 * c) * 33 + n;
        u32x4 o; o.x = cvt_pk_bf16(s[0 * 33], s[1 * 33]); o.y = cvt_pk_bf16(s[2 * 33], s[3 * 33]); o.z = cvt_pk_bf16(s[4 * 33], s[5 * 33]); o.w = cvt_pk_bf16(s[6 * 33], s[7 * 33]);
        *(u32x4*)(WT + (size_t)(destrow(mode, n0 + n) + row_off) * K + k0 + 8 * c) = o; }
    LDS_WAIT(); asm volatile("" ::: "memory");
}
__device__ __forceinline__ void p0_transpose_item8(const float* W, int K, int N, unsigned char* WT, int mode, int row_off, float scale, LAS float* scr, int item, int lane) {
    const int nblk = N / 32, kb = item / nblk, nb = item % nblk, k0 = 64 * kb, n0 = 32 * nb;
    float t_[32];
#pragma unroll
    for (int i = 0; i < 32; ++i) { const int kk = 2 * i + (lane >> 5); t_[i] = __builtin_nontemporal_load(W + (size_t)(k0 + kk) * N + n0 + (lane & 31)); }
#pragma unroll
    for (int i = 0; i < 32; ++i) { const int kk = 2 * i + (lane >> 5); scr[kk * 33 + (lane & 31)] = t_[i] * scale; }
    LDS_WAIT(); asm volatile("" ::: "memory");
    const int c = lane & 3;
#pragma unroll
    for (int j = 0; j < 2; ++j) { const int n = (lane >> 2) + 16 * j; const LAS float* s = scr + (16 * c) * 33 + n; u32x4 o;
#pragma unroll
        for (int q = 0; q < 4; ++q) { int t = __builtin_amdgcn_cvt_pk_fp8_f32(s[(4 * q) * 33], s[(4 * q + 1) * 33], 0, false); t = __builtin_amdgcn_cvt_pk_fp8_f32(s[(4 * q + 2) * 33], s[(4 * q + 3) * 33], t, true); o[q] = (unsigned)t; }
        *(u32x4*)(WT + (size_t)(destrow(mode, n0 + n) + row_off) * K + k0 + 16 * c) = o; }
    LDS_WAIT(); asm volatile("" ::: "memory");
}
__device__ __forceinline__ void p0_transpose_item_i8(const float* W, int K, int N, unsigned char* WT, int mode, int row_off, float scale, LAS float* scr, int item, int lane) {
    const int nblk = N / 32, kb = item / nblk, nb = item % nblk, k0 = 64 * kb, n0 = 32 * nb;
    float t_[32];
#pragma unroll
    for (int i = 0; i < 32; ++i) { const int kk = 2 * i + (lane >> 5); t_[i] = __builtin_nontemporal_load(W + (size_t)(k0 + kk) * N + n0 + (lane & 31)); }
#pragma unroll
    for (int i = 0; i < 32; ++i) { const int kk = 2 * i + (lane >> 5); scr[kk * 33 + (lane & 31)] = t_[i] * scale; }
    LDS_WAIT(); asm volatile("" ::: "memory");
    const int c = lane & 3;
#pragma unroll
    for (int j = 0; j < 2; ++j) { const int n = (lane >> 2) + 16 * j; const LAS float* s = scr + (16 * c) * 33 + n; u32x4 o;
#pragma unroll
        for (int q = 0; q < 4; ++q) { unsigned w = 0u;
#pragma unroll
            for (int b = 0; b < 4; ++b) { int v = __float2int_rn(s[(4 * q + b) * 33]); v = v > 127 ? 127 : (v < -127 ? -127 : v); w |= ((unsigned)v & 0xffu) << (8 * b); }
            o[q] = w; }
        *(u32x4*)(WT + (size_t)(destrow(mode, n0 + n) + row_off) * K + k0 + 16 * c) = o; }
    LDS_WAIT(); asm volatile("" ::: "memory");
}
template <class XT> __device__ __forceinline__ void rms_row_bf16(const XT* xrow, const float* g, bf16_t* orow, int lane) {
    f32x4 v[8]; float s = 0.f;
#pragma unroll
    for (int j = 0; j < 8; ++j) { v[j] = ldrow4(xrow + 4 * (lane + 64 * j)); s += (v[j][0] * v[j][0] + v[j][1] * v[j][1]) + (v[j][2] * v[j][2] + v[j][3] * v[j][3]); }
    const float rstd = 1.0f / sqrtf(wave_sum(s) * (1.f / DM) + EPS);
    const f32x4* gr = (const f32x4*)g + lane; u32x2* o8 = (u32x2*)orow + lane;
#pragma unroll
    for (int j = 0; j < 8; ++j) { const f32x4 gv = gr[64 * j]; const f32x4 y = v[j] * rstd * gv; u32x2 w; w.x = cvt_pk_bf16(y[0], y[1]); w.y = cvt_pk_bf16(y[2], y[3]); o8[64 * j] = w; }
}

template <int W> __device__ __forceinline__ void pool_rows(const res_t* xc, bf16_t* oc, const LAS float* rs, const f32x4 gv, int s0) {
    f32x4 prev[16], cur[16]; f32x4 S = {0.f, 0.f, 0.f, 0.f};
#pragma unroll
    for (int j = 0; j < 16; ++j) prev[j] = (f32x4){0.f, 0.f, 0.f, 0.f};
    if (s0 > 0) {
#pragma unroll
        for (int j = 1; j < W; ++j) { prev[16 - j] = ldres4(xc - (size_t)j * DM) * rs[16 - j] * gv; S += prev[16 - j]; } }
#pragma unroll 1
    for (int c = 0; c < 4; ++c) {
#pragma unroll
        for (int i = 0; i < 16; ++i) cur[i] = ldres4(xc + (size_t)(c * 16 + i) * DM);
#pragma unroll
        for (int i = 0; i < 16; ++i) { const int s = s0 + c * 16 + i; cur[i] = cur[i] * rs[16 + c * 16 + i] * gv; S += cur[i];
            const float inv = (s + 1 < W) ? 1.0f / (float)(s + 1) : 1.0f / (float)W; const f32x4 p = S * inv - cur[i];
            u32x2 o; o.x = cvt_pk_bf16(p[0], p[1]); o.y = cvt_pk_bf16(p[2], p[3]); *(u32x2*)(oc + (size_t)(c * 16 + i) * DM) = o;
            S -= (i - (W - 1) >= 0) ? cur[i - (W - 1) >= 0 ? i - (W - 1) : 0] : prev[16 + i - (W - 1) < 16 ? 16 + i - (W - 1) : 15]; }
#pragma unroll
        for (int i = 0; i < 16; ++i) prev[i] = cur[i];
    }
}
constexpr int CI_IN = 32 * (INC / 32), CI_UQ = 8 * 48, CI_UKV = 4 * 64, CI_OUT = 32 * 64, CI_FGU = 32 * 176, CI_FDN = 88 * 64, CI_PL = 8 * 16, CI_MGU = 32 * 88, CI_MDN = 44 * 64;
constexpr int CV_MOE = 16 * CI_MGU + 8 * CI_MDN, CV_FFN = 2 * CI_FGU + CI_FDN, CV_ALL = CV_MOE + CV_FFN + CI_IN + CI_OUT + CI_UQ + CI_UKV + 4 * CI_PL;
__device__ __forceinline__ void conv_item(const __attribute__((address_space(4))) Args* A_, unsigned char* ws, int r, LAS float* scr, int lane, float i8scale = 1.f) {
    if (r < 16 * CI_MGU) { const int w = r / (8 * CI_MGU), rr = r % (8 * CI_MGU), e = rr / CI_MGU, ii = rr % CI_MGU;
        p0_transpose_item8(A_->in[w ? I_MU : I_MG] + (size_t)e * DM * FE, DM, FE, ws + WS_W_MGU + (size_t)e * 2 * FE * DM, 3, w ? 128 : 0, 64.f, scr, ii, lane); return; } r -= 16 * CI_MGU;
    if (r < 8 * CI_MDN) { const int e = r / CI_MDN, ii = r % CI_MDN; p0_transpose_item8(A_->in[I_MD] + (size_t)e * FE * DM, FE, DM, ws + WS_W_MDN + (size_t)e * DM * FE, 0, 0, 64.f, scr, ii, lane); return; } r -= 8 * CI_MDN;
    if (r < 2 * CI_FGU) { const int w = r / CI_FGU, ii = r % CI_FGU;
        if (FFN_UP_I8) p0_transpose_item_i8(A_->in[w ? I_FU : I_FG], DM, FF, ws + WS_W_GU, 3, w ? 128 : 0, i8scale, scr, ii, lane); else if (FFN_UP_FP8) p0_transpose_item8(A_->in[w ? I_FU : I_FG], DM, FF, ws + WS_W_GU, 3, w ? 128 : 0, 64.f, scr, ii, lane); else p0_transpose_item(A_->in[w ? I_FU : I_FG], DM, FF, (bf16_t*)(ws + WS_W_GU), 3, w ? 128 : 0, scr, ii, lane); return; } r -= 2 * CI_FGU;
    if (r < CI_FDN) { if (FFN_DN_FP8) p0_transpose_item8(A_->in[I_FD], FF, DM, ws + WS_W_DN, 0, 0, 64.f, scr, r, lane); else p0_transpose_item(A_->in[I_FD], FF, DM, (bf16_t*)(ws + WS_W_DN), 0, 0, scr, r, lane); return; } r -= CI_FDN;
    if (r < CI_IN) { p0_transpose_item(A_->in[I_WIN], DM, INC, (bf16_t*)(ws + WS_W_IN), 1, 0, scr, r, lane); return; } r -= CI_IN;
    if (r < CI_OUT) { p0_transpose_item(A_->in[I_WOUT], DM, DM, (bf16_t*)(ws + WS_W_OUT), 0, 0, scr, r, lane); return; } r -= CI_OUT;
    if (r < CI_UQ) { p0_transpose_item(A_->in[I_WUQ], QLORA, NH * QKD, (bf16_t*)(ws + WS_W_UQ), 2, 0, scr, r, lane, FOLD_QKV_NORM ? A_->in[I_QNORM] : nullptr); return; } r -= CI_UQ;
    if (r < CI_UKV) { p0_transpose_item(A_->in[I_WUKV], KVLORA, NH * 256, (bf16_t*)(ws + WS_W_UKV), 0, 0, scr, r, lane, FOLD_QKV_NORM ? A_->in[I_KVNORM] : nullptr); return; } r -= CI_UKV;
    { const int gidx = r / CI_PL, ii = r % CI_PL; p0_transpose_item(A_->in[I_POOLW] + (size_t)gidx * 512 * 512, 512, 512, (bf16_t*)(ws + WS_W_POOL), 0, gidx * 512, scr, ii, lane); }
}
__device__ __forceinline__ void conv_colblock_i8(const __attribute__((address_space(4))) Args* A_, unsigned char* ws, int blkid, LAS unsigned char* lds, int wave, int lane) {
    const int w = blkid / (FF / 32), nb = blkid % (FF / 32), n0 = nb * 32, row_off = w ? 128 : 0;
    const float* W = A_->in[w ? I_FU : I_FG]; unsigned char* WT = ws + WS_W_GU; float* wsc = (float*)(ws + WS_MISC + MS_WSC);
    LAS float* scr = (LAS float*)(lds + wave * 16384); LAS float* cm = (LAS float*)(lds + 9216);
    float t[4][32]; float mx = 0.f;
    { const float* p = W + (size_t)(wave * 256 + (lane >> 5)) * FF + n0 + (lane & 31);
#pragma unroll
      for (int j = 0; j < 4; ++j)
#pragma unroll
        for (int i = 0; i < 32; ++i) { t[j][i] = __builtin_nontemporal_load(p); p += 2 * FF; if ((i & 7) == 7) asm volatile("" : "+v"(p)); } }
#pragma unroll
    for (int j = 0; j < 4; ++j)
#pragma unroll
        for (int i = 0; i < 32; ++i) mx = fmaxf(mx, fabsf(t[j][i]));
    mx = fmaxf(mx, __shfl_xor(mx, 32));
    if (lane < 32) cm[wave * 32 + lane] = mx;
    __syncthreads();
    float cmax = 0.f;
#pragma unroll
    for (int v = 0; v < 8; ++v) cmax = fmaxf(cmax, cm[v * 32 + (lane & 31)]);
    cmax = fmaxf(cmax, 1e-30f); const float sc = 127.f / cmax;
    if (wave == 0 && lane < 32) wsc[destrow(3, n0 + lane) + row_off] = cmax * (1.f / 127.f);
#pragma unroll
    for (int j = 0; j < 4; ++j) { const int k0 = wave * 256 + j * 64;
#pragma unroll
        for (int i = 0; i < 32; ++i) scr[(2 * i + (lane >> 5)) * 33 + (lane & 31)] = t[j][i] * sc;
        LDS_WAIT(); asm volatile("" ::: "memory");
        const int c = lane & 3;
#pragma unroll
        for (int jj = 0; jj < 2; ++jj) { const int n = (lane >> 2) + 16 * jj; const LAS float* sp = scr + (16 * c) * 33 + n; u32x4 o;
#pragma unroll
            for (int q = 0; q < 4; ++q) { unsigned wd = 0u;
#pragma unroll
                for (int b = 0; b < 4; ++b) { int v = __float2int_rn(sp[(4 * q + b) * 33]); v = v > 127 ? 127 : (v < -127 ? -127 : v); wd |= ((unsigned)v & 0xffu) << (8 * b); }
                o[q] = wd; }
            *(u32x4*)(WT + (size_t)(destrow(3, n0 + n) + row_off) * DM + k0 + 16 * c) = o; }
        LDS_WAIT(); asm volatile("" ::: "memory"); }
    __syncthreads();
}
__device__ __forceinline__ void conv_group(const __attribute__((address_space(4))) Args* A_, unsigned char* ws, int lo, int n, int blk, int G, int wave, LAS unsigned char* lds, int lane, float i8scale = 1.f) {
    const int grp = (blk >> 3) & 1, cu = (blk >> 4) * 8 + (blk & 7), NW = (G / 2) * NWAVES, half = n / 2;
    LAS float* scr = (LAS float*)(lds + wave * 16384);
    for (int it = cu * NWAVES + wave; it < half; it += NW) conv_item(A_, ws, lo + grp * half + it, scr, lane, i8scale);
    if (grp == 1 && (n & 1)) { if (cu == 0 && wave == 0) conv_item(A_, ws, lo + n - 1, scr, lane, i8scale); }
}
template <class XT> __device__ __forceinline__ void rms_row_i8(const XT* xrow, const float* g, unsigned char* orow, float* asc, int lane) {
    f32x4 v[8]; float s = 0.f;
#pragma unroll
    for (int j = 0; j < 8; ++j) { v[j] = ldrow4(xrow + 4 * (lane + 64 * j)); s += (v[j][0] * v[j][0] + v[j][1] * v[j][1]) + (v[j][2] * v[j][2] + v[j][3] * v[j][3]); }
    const float rstd = 1.0f / sqrtf(wave_sum(s) * (1.f / DM) + EPS);
    const f32x4* gr = (const f32x4*)g + lane; float mx = 0.f;
#pragma unroll
    for (int j = 0; j < 8; ++j) { v[j] = v[j] * rstd * gr[64 * j]; mx = fmaxf(fmaxf(mx, fmaxf(fabsf(v[j][0]), fabsf(v[j][1]))), fmaxf(fabsf(v[j][2]), fabsf(v[j][3]))); }
#pragma unroll
    for (int o = 1; o < 64; o <<= 1) mx = fmaxf(mx, __shfl_xor(mx, o));
    mx = fmaxf(mx, 1e-20f); const float sc = 127.f / mx; unsigned* o4 = (unsigned*)orow + lane;
#pragma unroll
    for (int j = 0; j < 8; ++j) { unsigned w = 0u;
#pragma unroll
        for (int b = 0; b < 4; ++b) { int q = __float2int_rn(v[j][b] * sc); q = q > 127 ? 127 : (q < -127 ? -127 : q); w |= ((unsigned)q & 0xffu) << (8 * b); }
        o4[64 * j] = w; }
    if (lane == 0) *asc = mx * (1.f / 127.f);
}
template <class XT> __device__ __forceinline__ void rms_row_fp8(const XT* xrow, const float* g, unsigned char* orow, int lane) {
    f32x4 v[8]; float s = 0.f;
#pragma unroll
    for (int j = 0; j < 8; ++j) { v[j] = ldrow4(xrow + 4 * (lane + 64 * j)); s += (v[j][0] * v[j][0] + v[j][1] * v[j][1]) + (v[j][2] * v[j][2] + v[j][3] * v[j][3]); }
    const float rstd = 1.0f / sqrtf(wave_sum(s) * (1.f / DM) + EPS);
    const f32x4* gr = (const f32x4*)g + lane; unsigned* o4 = (unsigned*)orow + lane;
#pragma unroll
    for (int j = 0; j < 8; ++j) { const f32x4 y = v[j] * rstd * gr[64 * j]; int t = __builtin_amdgcn_cvt_pk_fp8_f32(y[0], y[1], 0, false); t = __builtin_amdgcn_cvt_pk_fp8_f32(y[2], y[3], t, true); o4[64 * j] = (unsigned)t; }
}

__device__ __forceinline__ void conv_rowblock(int rb, const bf16_t* PROJ, bf16_t* YAB, const float* cw, int tid) {
    const int ch = (tid & 127) * 8, seg = tid >> 7, t0 = rb * 64 + seg * 16, s0 = t0 & (SEQ - 1);
    float w0[8], w1[8], w2[8], u1[8], u2[8];
#pragma unroll
    for (int j = 0; j < 8; ++j) { w0[j] = cw[ch + j]; w1[j] = cw[CONV + ch + j]; w2[j] = cw[2 * CONV + ch + j]; u1[j] = 0.f; u2[j] = 0.f; }
#pragma unroll
    for (int back = 2; back >= 1; --back) if (s0 >= back) { const bf16_t* pr = PROJ + (size_t)(t0 - back) * 3072 + ch; const u32x4 xi = *(const u32x4*)pr, gc = *(const u32x4*)(pr + 2048);
        float uu[8];
#pragma unroll
        for (int j = 0; j < 4; ++j) { uu[2 * j] = bflo(xi[j]) * bflo(gc[j]); uu[2 * j + 1] = bfhi(xi[j]) * bfhi(gc[j]); }
#pragma unroll
        for (int j = 0; j < 8; ++j) { if (back == 2) u2[j] = uu[j]; else u1[j] = uu[j]; } }
    for (int i = 0; i < 16; ++i) { const bf16_t* pr = PROJ + (size_t)(t0 + i) * 3072 + ch; const u32x4 xi = *(const u32x4*)pr, gb = *(const u32x4*)(pr + 1024), gc = *(const u32x4*)(pr + 2048);
        float uu[8], gbf[8], y[8];
#pragma unroll
        for (int j = 0; j < 4; ++j) { uu[2 * j] = bflo(xi[j]) * bflo(gc[j]); uu[2 * j + 1] = bfhi(xi[j]) * bfhi(gc[j]); gbf[2 * j] = bflo(gb[j]); gbf[2 * j + 1] = bfhi(gb[j]); }
#pragma unroll
        for (int j = 0; j < 8; ++j) { y[j] = gbf[j] * (w0[j] * u2[j] + w1[j] * u1[j] + w2[j] * uu[j]); u2[j] = u1[j]; u1[j] = uu[j]; }
        u32x4 o; o.x = cvt_pk_bf16(y[0], y[1]); o.y = cvt_pk_bf16(y[2], y[3]); o.z = cvt_pk_bf16(y[4], y[5]); o.w = cvt_pk_bf16(y[6], y[7]);
        *(u32x4*)(YAB + (size_t)(t0 + i) * DM + ch) = o; }
}

__global__ void __launch_bounds__(NTHREADS, 2) fwd_kernel(Args args) {
    extern __shared__ __attribute__((aligned(16))) unsigned char lds_raw[];
    Frame F;
    F.lds = (LAS unsigned char*)lds_raw;
    F.wave = __builtin_amdgcn_readfirstlane((int)threadIdx.x >> 6);
    F.G = gridDim.x; F.blk = blockIdx.x; F.vcu = (F.G % 8 == 0) ? (F.blk % 8) * (F.G / 8) + F.blk / 8 : F.blk;
    unsigned* ctl = (unsigned*)(args.ws + WS_CTL);
    const int lo = args.ph_lo, hi = args.ph_hi;
    if (threadIdx.x < 4) ((LAS unsigned*)(F.lds + LX_BAR))[threadIdx.x] = 0u;
    __syncthreads();
    XcdBarrier bar; bar.bar = ctl + CW_BAR; bar.x = 0; bar.st = nullptr;
    if (hi - lo > 1) bar = xcd_barrier_post(ctl + CW_BAR, (volatile LAS unsigned*)(F.lds + LX_BAR));
#define IN(k) (lo <= (k) && (k) < hi)
#define PHASE_PTRS() \
    const __attribute__((address_space(4))) Args* A_ = (const __attribute__((address_space(4))) Args*)__builtin_amdgcn_kernarg_segment_ptr(); asm volatile("" : "+s"(A_)); \
    int tid_ = threadIdx.x; asm volatile("" : "+v"(tid_)); const int tid = tid_, lane = tid_ & 63; (void)tid; (void)lane; \
    unsigned char* ws = A_->ws; const float* x = A_->in[I_X]; res_t* XR = RES_BF16 ? (res_t*)(ws + WS_XRB) : (res_t*)A_->out; (void)x; (void)XR; \
    float* ROPE = (float*)(ws + WS_ROPE); (void)ROPE; \
    bf16_t* W_IN = (bf16_t*)(ws + WS_W_IN); bf16_t* W_UQ = (bf16_t*)(ws + WS_W_UQ); bf16_t* W_UKV = (bf16_t*)(ws + WS_W_UKV); bf16_t* W_OUT = (bf16_t*)(ws + WS_W_OUT); \
    bf16_t* W_GU = (bf16_t*)(ws + WS_W_GU); bf16_t* W_DN = (bf16_t*)(ws + WS_W_DN); bf16_t* W_POOL = (bf16_t*)(ws + WS_W_POOL); bf16_t* W_MGU = (bf16_t*)(ws + WS_W_MGU); bf16_t* W_MDN = (bf16_t*)(ws + WS_W_MDN); \
    bf16_t* XBA = (bf16_t*)(ws + WS_XBA); bf16_t* XBB = (bf16_t*)(ws + WS_XBB); \
    bf16_t* PROJ = (bf16_t*)(ws + WS_PROJ); bf16_t* QB = (bf16_t*)(ws + WS_Q); bf16_t* KNB = (bf16_t*)(ws + WS_KN); bf16_t* CQ = (bf16_t*)(ws + WS_CQ); bf16_t* CKV = (bf16_t*)(ws + WS_CKV); \
    bf16_t* KRB = (bf16_t*)(ws + WS_KR); bf16_t* VB = (bf16_t*)(ws + WS_V); bf16_t* YAB = (bf16_t*)(ws + WS_YAB); bf16_t* HB = (bf16_t*)(ws + WS_H); bf16_t* HMOE = (bf16_t*)(ws + WS_HMOE); bf16_t* YMOE = (bf16_t*)(ws + WS_YMOE); \
    int* TOPI = (int*)(ws + WS_MISC + MS_TOPI); float* TOPP = (float*)(ws + WS_MISC + MS_TOPP); int* CNT = (int*)(ws + WS_MISC + MS_CNT); \
    int* PERM = (int*)(ws + WS_MISC + MS_PERM); float* GATE = (float*)(ws + WS_MISC + MS_GATE); int* DEST = (int*)(ws + WS_MISC + MS_DEST); int* TILE = (int*)(ws + WS_MISC + MS_TILE); \
    (void)W_IN; (void)W_UQ; (void)W_UKV; (void)W_OUT; (void)W_GU; (void)W_DN; (void)W_POOL; (void)W_MGU; (void)W_MDN; (void)XBA; (void)XBB; (void)PROJ; (void)QB; (void)KNB; (void)CQ; (void)CKV; (void)KRB; (void)VB; (void)YAB; (void)HB; (void)HMOE; (void)YMOE; \
    (void)TOPI; (void)TOPP; (void)CNT; (void)PERM; (void)GATE; (void)DEST; (void)TILE
#define AIN(i) (A_->in[i])
#define SEAM(k) do { if (IN(k) && IN((k) + 1)) xcd_barrier(bar); } while (0)

    const int gw = F.vcu * NWAVES + F.wave, NGW = F.G * NWAVES;

    if (IN(PH_PRO)) { PHASE_PTRS();
        LAS float* scr = (LAS float*)(F.lds + F.wave * 16384);
        for (int it = (OVERLAP_CONV ? CV_MOE + CV_FFN : 0) + gw; it < CV_ALL; it += NGW) conv_item(A_, ws, it, scr, lane);
        if (FFN_UP_I8 && !I8_PERCOL) {
            const int gt = F.vcu * NTHREADS + tid, NGT = F.G * NTHREADS; float mx = 0.f;
#pragma unroll 1
            for (int w = 0; w < 2; ++w) { const f32x4* p = (const f32x4*)AIN(w ? I_FU : I_FG);
#pragma unroll 4
                for (int i = gt; i < DM * FF / 4; i += NGT) { const f32x4 v = __builtin_nontemporal_load(p + i); mx = fmaxf(fmaxf(mx, fmaxf(fabsf(v[0]), fabsf(v[1]))), fmaxf(fabsf(v[2]), fabsf(v[3]))); } }
#pragma unroll
            for (int o = 1; o < 64; o <<= 1) mx = fmaxf(mx, __shfl_xor(mx, o));
            if (lane == 0) atomicMax((unsigned*)(ws + WS_CTL) + CW_WMAX, __float_as_uint(mx)); }
        { const int gt = F.vcu * NTHREADS + tid, NGT = F.G * NTHREADS; u32x4* z = (u32x4*)(W_IN + (size_t)INC * DM);
          for (int i = gt; i < (INP - INC) * DM / 8; i += NGT) z[i] = (u32x4){0u, 0u, 0u, 0u};
          for (int i = gt; i < SEQ * 32; i += NGT) { const int pos = i >> 5, k = i & 31; const float ang = (float)pos * A_->inv_freq[k];
              double sn, cs; sincos_d((double)ang, sn, cs); ROPE[pos * 64 + k] = (float)cs; ROPE[pos * 64 + 32 + k] = (float)sn; } }
        for (int m = gw; m < M; m += NGW) rms_row_bf16(x + (size_t)m * DM, AIN(I_NMIX0), XBA + (size_t)m * DM, lane);
    }
    SEAM(PH_PRO);

    if (IN(PH_PROJ)) { PHASE_PTRS();
        pg8::GemmDesc g{XBA, W_IN, DM, DM, DM, 0, 0}; pg8::StaticOrder S; S.init(M / 256, INP / 256, F.G, F.blk, DM, DM);
        pg8::EpiProj E{PROJ, CQ, CKV, KRB, ROPE, FOLD_QKV_NORM ? (float*)(ws + WS_MISC + MS_SSQ2) : nullptr};
        const int cgrp = (F.blk >> 3) & 1;
        const float i8s = (FFN_UP_I8 && !I8_PERCOL) ? 127.f / __uint_as_float(__hip_atomic_load((unsigned*)(ws + WS_CTL) + CW_WMAX, __ATOMIC_RELAXED, __HIP_MEMORY_SCOPE_AGENT)) : 1.f;
        constexpr bool PC = FFN_UP_I8 && I8_PERCOL;
        constexpr int FLO = PC ? CV_MOE + 2 * CI_FGU : CV_MOE, FN = PC ? CI_FDN : CV_FFN, NCB = 2 * (FF / 32);
        if (OVERLAP_CONV && F.G % 16 == 0 && cgrp == 0) { const int cu = (F.blk >> 4) * 8 + (F.blk & 7);
            if (PC) { __syncthreads(); for (int b = cu; b < NCB / 2; b += F.G / 2) conv_colblock_i8(A_, ws, b, F.lds, F.wave, lane); }
            conv_group(A_, ws, FLO, FN, F.blk, F.G, F.wave, F.lds, lane, i8s); __syncthreads(); }
        pg8::gemm_phase<pg8::EpiProj, pg8::StaticOrder, true, false>(F.lds, g, S, E, tid);
        if (OVERLAP_CONV && F.G % 16 == 0 && cgrp == 1) { const int cu = (F.blk >> 4) * 8 + (F.blk & 7);
            if (PC) { for (int b = cu; b < NCB / 2; b += F.G / 2) conv_colblock_i8(A_, ws, NCB / 2 + b, F.lds, F.wave, lane); }
            conv_group(A_, ws, FLO, FN, F.blk, F.G, F.wave, F.lds, lane, i8s); }
        if (OVERLAP_CONV && F.G % 16 != 0) { if (PC) { for (int b = F.blk; b < NCB; b += F.G) conv_colblock_i8(A_, ws, b, F.lds, F.wave, lane); }
            LAS float* scr = (LAS float*)(F.lds + F.wave * 16384); for (int it = FLO + gw; it < FLO + FN; it += NGW) conv_item(A_, ws, it, scr, lane, i8s); }
    }
    SEAM(PH_PROJ);

#if !FOLD_QKV_NORM
    if (IN(PH_CONV)) { PHASE_PTRS();
        const float* cw = AIN(I_CONVW);
        for (int rb = F.blk; rb < M / 64; rb += F.G) {
            const int ch = (tid & 127) * 8, seg = tid >> 7, t0 = rb * 64 + seg * 16, s0 = t0 & (SEQ - 1);
            float w0[8], w1[8], w2[8], u1[8], u2[8];
#pragma unroll
            for (int j = 0; j < 8; ++j) { w0[j] = cw[ch + j]; w1[j] = cw[CONV + ch + j]; w2[j] = cw[2 * CONV + ch + j]; u1[j] = 0.f; u2[j] = 0.f; }
#pragma unroll
            for (int back = 2; back >= 1; --back) if (s0 >= back) { const bf16_t* pr = PROJ + (size_t)(t0 - back) * 3072 + ch; const u32x4 xi = *(const u32x4*)pr, gc = *(const u32x4*)(pr + 2048);
                float uu[8];
#pragma unroll
                for (int j = 0; j < 4; ++j) { uu[2 * j] = bflo(xi[j]) * bflo(gc[j]); uu[2 * j + 1] = bfhi(xi[j]) * bfhi(gc[j]); }
#pragma unroll
                for (int j = 0; j < 8; ++j) { if (back == 2) u2[j] = uu[j]; else u1[j] = uu[j]; } }
            for (int i = 0; i < 16; ++i) { const bf16_t* pr = PROJ + (size_t)(t0 + i) * 3072 + ch; const u32x4 xi = *(const u32x4*)pr, gb = *(const u32x4*)(pr + 1024), gc = *(const u32x4*)(pr + 2048);
                float uu[8], gbf[8], y[8];
#pragma unroll
                for (int j = 0; j < 4; ++j) { uu[2 * j] = bflo(xi[j]) * bflo(gc[j]); uu[2 * j + 1] = bfhi(xi[j]) * bfhi(gc[j]); gbf[2 * j] = bflo(gb[j]); gbf[2 * j + 1] = bfhi(gb[j]); }
#pragma unroll
                for (int j = 0; j < 8; ++j) { y[j] = gbf[j] * (w0[j] * u2[j] + w1[j] * u1[j] + w2[j] * uu[j]); u2[j] = u1[j]; u1[j] = uu[j]; }
                u32x4 o; o.x = cvt_pk_bf16(y[0], y[1]); o.y = cvt_pk_bf16(y[2], y[3]); o.z = cvt_pk_bf16(y[4], y[5]); o.w = cvt_pk_bf16(y[6], y[7]);
                *(u32x4*)(YAB + (size_t)(t0 + i) * DM + ch) = o; }
            for (int i = 0; i < 8; ++i) { const int row = rb * 64 + F.wave * 8 + i;
                { bf16_t* p = CQ + (size_t)row * QLORA + lane * 8; const u32x4 v = *(const u32x4*)p; float f[8], s = 0.f;
#pragma unroll
                  for (int j = 0; j < 4; ++j) { f[2 * j] = bflo(v[j]); f[2 * j + 1] = bfhi(v[j]); s += f[2 * j] * f[2 * j] + f[2 * j + 1] * f[2 * j + 1]; }
                  const float rstd = 1.0f / sqrtf(wave_sum(s) * (1.f / QLORA) + EPS); const float* gq = AIN(I_QNORM) + lane * 8;
                  u32x4 o; o.x = cvt_pk_bf16(f[0] * rstd * gq[0], f[1] * rstd * gq[1]); o.y = cvt_pk_bf16(f[2] * rstd * gq[2], f[3] * rstd * gq[3]);
                  o.z = cvt_pk_bf16(f[4] * rstd * gq[4], f[5] * rstd * gq[5]); o.w = cvt_pk_bf16(f[6] * rstd * gq[6], f[7] * rstd * gq[7]); *(u32x4*)p = o; }
                { bf16_t* p = CKV + (size_t)row * KVLORA + lane * 4; const u32x2 v = *(const u32x2*)p; float f[4], s = 0.f;
#pragma unroll
                  for (int j = 0; j < 2; ++j) { f[2 * j] = bflo(v[j]); f[2 * j + 1] = bfhi(v[j]); s += f[2 * j] * f[2 * j] + f[2 * j + 1] * f[2 * j + 1]; }
                  const float rstd = 1.0f / sqrtf(wave_sum(s) * (1.f / KVLORA) + EPS); const float* gk = AIN(I_KVNORM) + lane * 4;
                  u32x2 o; o.x = cvt_pk_bf16(f[0] * rstd * gk[0], f[1] * rstd * gk[1]); o.y = cvt_pk_bf16(f[2] * rstd * gk[2], f[3] * rstd * gk[3]); *(u32x2*)p = o; } }
        }
    }
    SEAM(PH_CONV);

#endif

    if (IN(PH_QKV)) { PHASE_PTRS();
#if FOLD_QKV_NORM
        const float* ssq2 = (const float*)(ws + WS_MISC + MS_SSQ2);
        { pg8::GemmDesc g{CKV, W_UKV, KVLORA, KVLORA, KVLORA, 0, 0}; pg8::StaticOrder S; S.init(M / 256, NH, F.G, F.blk, KVLORA, KVLORA);
          pg8::EpiKV E{KNB, VB, ssq2}; pg8::gemm_phase<pg8::EpiKV, pg8::StaticOrder, true, false>(F.lds, g, S, E, tid); }
        { pg8::GemmDesc g{CQ, W_UQ, QLORA, QLORA, QLORA, 0, 0}; pg8::StaticOrder S; S.init(M / 256, NH * QKD / 256, F.G, F.blk, QLORA, QLORA);
          int tidq = tid; asm volatile("" : "+v"(tidq));
          pg8::EpiQ E{QB, ROPE, ssq2}; pg8::gemm_phase<pg8::EpiQ, pg8::StaticOrder, true, false>(F.lds, g, S, E, tidq); }
        { constexpr int NQU = (M / 256) * (NH * QKD / 256), NRB = M / 64; const float* cw = AIN(I_CONVW);
          const int r = NQU % F.G, nidle = r ? F.G - r : F.G, me = r ? F.blk - r : F.blk;
          int tid2 = tid; asm volatile("" : "+v"(tid2));
          if (me >= 0) for (int rb = me; rb < NRB; rb += nidle) conv_rowblock(rb, PROJ, YAB, cw, tid2); }
#else
        { pg8::GemmDesc g{CQ, W_UQ, QLORA, QLORA, QLORA, 0, 0}; pg8::StaticOrder S; S.init(M / 256, NH * QKD / 256, F.G, F.blk, QLORA, QLORA);
          pg8::EpiQ E{QB, ROPE, nullptr}; pg8::gemm_phase<pg8::EpiQ, pg8::StaticOrder, true, false>(F.lds, g, S, E, tid); }
        { pg8::GemmDesc g{CKV, W_UKV, KVLORA, KVLORA, KVLORA, 0, 0}; pg8::StaticOrder S; S.init(M / 256, NH, F.G, F.blk, KVLORA, KVLORA);
          pg8::EpiKV E{KNB, VB, nullptr}; pg8::gemm_phase<pg8::EpiKV, pg8::StaticOrder, true, false>(F.lds, g, S, E, tid); }
#endif
    }
    SEAM(PH_QKV);

    if (IN(PH_ATTN)) { PHASE_PTRS();
        for (int L = F.vcu; L < 256; L += F.G) { const int bh = L >> 3, s = L & 7;
#pragma unroll 1
            for (int pass = 0; pass < 2; ++pass) att::attn_unit(bh >> 3, bh & 7, pass ? s : 15 - s, QB, KNB, KRB, VB, YAB, (char*)lds_raw, tid); }
    }
    SEAM(PH_ATTN);

    if (IN(PH_WOUT)) { PHASE_PTRS();
        pg8::GemmDesc g{YAB, W_OUT, DM, DM, DM, 0, 0}; pg8::StaticOrder S; S.init(M / 256, DM / 256, F.G, F.blk, DM, DM);
        #if RES_BF16
        pg8::EpiResB<false, true> E{x, XR, nullptr, nullptr}; pg8::gemm_phase<pg8::EpiResB<false, true>, pg8::StaticOrder, true, false>(F.lds, g, S, E, tid);
#else
        pg8::EpiRes<false> E{x, XR, nullptr, nullptr}; pg8::gemm_phase<pg8::EpiRes<false>, pg8::StaticOrder, true, false>(F.lds, g, S, E, tid);
#endif
    }
    SEAM(PH_WOUT);

    if (IN(PH_NORM1)) { PHASE_PTRS();
        for (int m = gw; m < M; m += NGW) {
            if (FFN_UP_I8) rms_row_i8(XR + (size_t)m * DM, AIN(I_NFFN0), (unsigned char*)XBA + (size_t)m * DM, (float*)(ws + WS_MISC + MS_ASC) + m, lane);
            else if (FFN_UP_FP8) rms_row_fp8(XR + (size_t)m * DM, AIN(I_NFFN0), (unsigned char*)XBA + (size_t)m * DM, lane);
            else rms_row_bf16(XR + (size_t)m * DM, AIN(I_NFFN0), XBA + (size_t)m * DM, lane); } }
    SEAM(PH_NORM1);

    if (IN(PH_FFNUP)) { PHASE_PTRS();
        constexpr int UPM = FFN_UP_I8 ? 2 : (FFN_UP_FP8 ? 1 : 0); constexpr int KD = UPM ? DM / 2 : DM;
        pg8::GemmDesc g{XBA, W_GU, KD, KD, KD, 0x79797979, 0x7f7f7f7f}; pg8::StaticOrder S; S.init(M / 256, 2 * FF / 256, F.G, F.blk, KD, KD);
        const float wdq = (FFN_UP_I8 && !I8_PERCOL) ? __uint_as_float(__hip_atomic_load((unsigned*)(ws + WS_CTL) + CW_WMAX, __ATOMIC_RELAXED, __HIP_MEMORY_SCOPE_AGENT)) * (1.f / 127.f) : 1.f;
        pg8::EpiSwiGLU<FFN_DN_FP8 != 0> E{HB, FF, nullptr, FFN_UP_I8 ? (const float*)(ws + WS_MISC + MS_ASC) : nullptr, wdq, (FFN_UP_I8 && I8_PERCOL) ? (const float*)(ws + WS_MISC + MS_WSC) : nullptr};
        const int cgrp = (F.blk >> 3) & 1;
        if (OVERLAP_CONV && F.G % 16 == 0 && cgrp == 0) { conv_group(A_, ws, 0, 8 * CI_MGU, F.blk, F.G, F.wave, F.lds, lane); __syncthreads(); }
        pg8::gemm_phase<pg8::EpiSwiGLU<FFN_DN_FP8 != 0>, pg8::StaticOrder, true, false, UPM>(F.lds, g, S, E, tid);
        if (OVERLAP_CONV && F.G % 16 == 0 && cgrp == 1) conv_group(A_, ws, 0, 8 * CI_MGU, F.blk, F.G, F.wave, F.lds, lane);
        if (OVERLAP_CONV && F.G % 16 != 0) { LAS float* scr = (LAS float*)(F.lds + F.wave * 16384); for (int it = gw; it < 8 * CI_MGU; it += NGW) conv_item(A_, ws, it, scr, lane); }
    }
    SEAM(PH_FFNUP);

    if (IN(PH_FFNDN)) { PHASE_PTRS();
        constexpr int KF = FFN_DN_FP8 ? FF / 2 : FF;
        pg8::GemmDesc g{HB, W_DN, KF, KF, KF, 0x79797979, 0x7d7d7d7d}; pg8::StaticOrder S; S.init(M / 256, DM / 256, F.G, F.blk, KF, KF);
        #if RES_BF16
        typedef pg8::EpiResB<true, false> EpiDn;
#else
        typedef pg8::EpiRes<true> EpiDn;
#endif
        EpiDn E{XR, XR, nullptr, (float*)(ws + WS_SSQ)}; const int cgrp6 = (F.blk >> 3) & 1;
        if (OVERLAP_CONV && F.G % 16 == 0 && cgrp6 == 0) { conv_group(A_, ws, 8 * CI_MGU, 8 * CI_MGU, F.blk, F.G, F.wave, F.lds, lane); __syncthreads(); }
        pg8::gemm_phase<EpiDn, pg8::StaticOrder, true, false, FFN_DN_FP8 ? 1 : 0>(F.lds, g, S, E, tid);
        if (OVERLAP_CONV && F.G % 16 == 0 && cgrp6 == 1) conv_group(A_, ws, 8 * CI_MGU, 8 * CI_MGU, F.blk, F.G, F.wave, F.lds, lane);
        if (OVERLAP_CONV && F.G % 16 != 0) { LAS float* scr = (LAS float*)(F.lds + F.wave * 16384); for (int it = 8 * CI_MGU + gw; it < 16 * CI_MGU; it += NGW) conv_item(A_, ws, it, scr, lane); }
    }
    SEAM(PH_FFNDN);

    if (IN(PH_POOL)) { PHASE_PTRS();
        LAS float* rs = (LAS float*)F.lds;
        const float* gm = AIN(I_NMIX1); const float* ssq = (const float*)(ws + WS_SSQ);
        for (int rb = F.blk; rb < M / 64; rb += F.G) {
            const int r0 = rb * 64, s0 = r0 & (SEQ - 1);
            __syncthreads();
            if (tid < 80) { const int row = r0 - 16 + tid; float rstd = 0.f;
                if (s0 - 16 + tid >= 0) { const f32x4* p = (const f32x4*)(ssq + (size_t)row * 32); float q = 0.f;
#pragma unroll
                    for (int j = 0; j < 8; ++j) { const f32x4 v = p[j]; q += (v[0] + v[1]) + (v[2] + v[3]); }
                    rstd = 1.0f / sqrtf(q * (1.f / DM) + EPS); }
                rs[tid] = rstd; }
            __syncthreads();
            const int c4 = tid * 4; const f32x4 gv = *(const f32x4*)(gm + c4); const res_t* xc = XR + (size_t)r0 * DM + c4; bf16_t* oc = XBB + (size_t)r0 * DM + c4;
            switch (tid >> 7) { case 0: pool_rows<2>(xc, oc, rs, gv, s0); break; case 1: pool_rows<4>(xc, oc, rs, gv, s0); break; case 2: pool_rows<8>(xc, oc, rs, gv, s0); break; default: pool_rows<16>(xc, oc, rs, gv, s0); break; }
        }
        __syncthreads();
    }
    SEAM(PH_POOL);

    if (IN(PH_POOLG)) { PHASE_PTRS();
        pg8::GemmDesc g{XBB, W_POOL, DM, 512, 512, 0, 0}; pg8::StaticOrder S; S.init(M / 256, DM / 256, F.G, F.blk, DM, 512, 2, 512);
        #if RES_BF16
        pg8::EpiResB<false, false> E{XR, XR, AIN(I_POOLS), nullptr}; pg8::gemm_phase<pg8::EpiResB<false, false>, pg8::StaticOrder, true, false>(F.lds, g, S, E, tid);
#else
        pg8::EpiRes<false> E{XR, XR, AIN(I_POOLS), nullptr}; pg8::gemm_phase<pg8::EpiRes<false>, pg8::StaticOrder, true, false>(F.lds, g, S, E, tid);
#endif
    }
    SEAM(PH_POOLG);

    if (IN(PH_ROUTE)) { PHASE_PTRS();
        LAS float* RW = (LAS float*)F.lds;
        LAS int* lcnt = (LAS int*)(F.lds + 65536);
        const float* gn = AIN(I_NFFN1); const float* rw = AIN(I_ROUTER);
        __syncthreads();
        for (int idx = tid; idx < 16384; idx += NTHREADS) { const int e3 = idx & 3, ln = (idx >> 2) & 63, half = (idx >> 8) & 1, jq = idx >> 9; const int c = 4 * (ln + 64 * (jq >> 2)) + (jq & 3);
            RW[idx] = rw[c * NE + half * 4 + e3] * gn[c]; }
        for (int rb = F.blk; rb < M / 64; rb += F.G) {
            if (tid < NE) lcnt[tid] = 0;
            __syncthreads();
            for (int i = 0; i < 8; ++i) { const int m = rb * 64 + F.wave * 8 + i;
                const res_t* xr = XR + (size_t)m * DM; f32x4 v[8]; float s = 0.f; float lg[8] = {0.f, 0.f, 0.f, 0.f, 0.f, 0.f, 0.f, 0.f};
#pragma unroll
                for (int j = 0; j < 8; ++j) { v[j] = ldres4(xr + 4 * (lane + 64 * j)); s += (v[j][0] * v[j][0] + v[j][1] * v[j][1]) + (v[j][2] * v[j][2] + v[j][3] * v[j][3]); }
#pragma unroll
                for (int j = 0; j < 8; ++j)
#pragma unroll
                    for (int q = 0; q < 4; ++q) { const int jq = j * 4 + q; const f32x4 wa = *(const LAS f32x4*)(RW + ((jq * 2 + 0) * 64 + lane) * 4), wb = *(const LAS f32x4*)(RW + ((jq * 2 + 1) * 64 + lane) * 4);
                        const float xv = v[j][q]; lg[0] += xv * wa[0]; lg[1] += xv * wa[1]; lg[2] += xv * wa[2]; lg[3] += xv * wa[3]; lg[4] += xv * wb[0]; lg[5] += xv * wb[1]; lg[6] += xv * wb[2]; lg[7] += xv * wb[3]; }
                const float rstd = 1.0f / sqrtf(wave_sum(s) * (1.f / DM) + EPS);
#pragma unroll
                for (int e = 0; e < 8; ++e) lg[e] = wave_sum(lg[e]) * rstd;
                int i1 = 0; float l1 = lg[0];
#pragma unroll
                for (int e = 1; e < 8; ++e) if (lg[e] > l1) { l1 = lg[e]; i1 = e; }
                int i2 = -1; float l2 = -__builtin_inff();
#pragma unroll
                for (int e = 0; e < 8; ++e) if (e != i1 && lg[e] > l2) { l2 = lg[e]; i2 = e; }
                const float p1 = 1.0f / (1.0f + expf(l2 - l1)), p2 = 1.0f - p1;
                if (lane == 0) { TOPI[2 * m] = i1; TOPI[2 * m + 1] = i2; TOPP[2 * m] = p1; TOPP[2 * m + 1] = p2; __hip_atomic_fetch_add(lcnt + i1, 1, __ATOMIC_RELAXED, __HIP_MEMORY_SCOPE_WORKGROUP); __hip_atomic_fetch_add(lcnt + i2, 1, __ATOMIC_RELAXED, __HIP_MEMORY_SCOPE_WORKGROUP); }
                const f32x4* gr = (const f32x4*)gn + lane; unsigned* o8 = (unsigned*)((unsigned char*)XBA + (size_t)m * DM) + lane;
#pragma unroll
                for (int j = 0; j < 8; ++j) { const f32x4 y = v[j] * rstd * gr[64 * j]; int t = __builtin_amdgcn_cvt_pk_fp8_f32(y[0], y[1], 0, false); t = __builtin_amdgcn_cvt_pk_fp8_f32(y[2], y[3], t, true); o8[64 * j] = (unsigned)t; } }
            __syncthreads();
            if (tid < NE) CNT[rb * NE + tid] = lcnt[tid];
            __syncthreads();
        }
        { const int gt = F.blk * NTHREADS + tid, NGT = F.G * NTHREADS; for (int i = gt; i < MOE_ROWS; i += NGT) { PERM[i] = 0; GATE[i] = 0.f; DEST[i] = -1; } }
    }
    SEAM(PH_ROUTE);

    if (IN(PH_SORT)) { PHASE_PTRS();
        LAS int* cl = (LAS int*)F.lds; LAS int* tot = cl + 2048; LAS int* pre = tot + 8; LAS int* base = pre + 8; LAS int* el = base + 16;
        for (int rb = F.blk; rb < M / 64; rb += F.G) {
            __syncthreads();
            for (int i = tid; i < 2048; i += NTHREADS) cl[i] = CNT[i];
            if (tid < 64) { el[2 * tid] = TOPI[2 * (rb * 64 + tid)]; el[2 * tid + 1] = TOPI[2 * (rb * 64 + tid) + 1]; }
            __syncthreads();
            if (tid < NE) { int t = 0, p = 0; for (int b = 0; b < 256; ++b) { const int c = cl[b * NE + tid]; t += c; if (b < rb) p += c; } tot[tid] = t; pre[tid] = p; }
            __syncthreads();
            if (tid == 0) { int bs = 0; for (int e = 0; e < NE; ++e) { base[e] = bs; bs += (tot[e] + 255) & ~255; } base[NE] = bs;
                if (rb == 0) { for (int e = 0; e < NE; ++e) for (int t = base[e] >> 8; t < (base[e + 1] >> 8); ++t) TILE[t] = e; TILE[159] = bs >> 8; } }
            __syncthreads();
            if (tid < 64) { const int m = rb * 64 + tid;
#pragma unroll
                for (int k = 0; k < 2; ++k) { const int e = el[2 * tid + k]; int rank = 0; for (int t = 0; t < 2 * tid; ++t) rank += (el[t] == e) ? 1 : 0;
                    const int pos = base[e] + pre[e] + rank; PERM[pos] = m; GATE[pos] = TOPP[2 * m + k]; DEST[pos] = 2 * m + k; } }
        }
        __syncthreads();
    }
    SEAM(PH_SORT);

    LAS int* tile_e = (LAS int*)(F.lds + LX_TILE);
    if (IN(PH_MOEUP) || IN(PH_MOEDN)) { PHASE_PTRS(); if (tid < 160) tile_e[tid] = TILE[tid]; __syncthreads(); }
    if (IN(PH_MOEUP)) { PHASE_PTRS();
        const int ntiles = __builtin_amdgcn_readfirstlane(tile_e[159]);
        pg8::GemmDesc g{XBA, W_MGU, DM / 2, DM / 2, DM / 2, 0x79797979, 0x7f7f7f7f}; pg8::MoeOrder S{ntiles, 2 * FE / 256, ntiles * (2 * FE / 256), F.G, F.blk, DM / 2, DM / 2, (size_t)FE * DM, tile_e, PERM, true};
        pg8::EpiSwiGLU<true> E{HMOE, FE, GATE, nullptr, 1.f, nullptr}; pg8::gemm_phase<pg8::EpiSwiGLU<true>, pg8::MoeOrder, true, true, 1>(F.lds, g, S, E, tid);
        if (OVERLAP_CONV) {
            const int nwg = ntiles * (2 * FE / 256), r = nwg % F.G, nidle = r ? F.G - r : F.G, me = r ? F.blk - r : F.blk;
            if (me >= 0) { LAS float* scr = (LAS float*)(F.lds + F.wave * 16384);
                for (int it = me * NWAVES + F.wave; it < 8 * CI_MDN; it += nidle * NWAVES) conv_item(A_, ws, 16 * CI_MGU + it, scr, lane); } }
    }
    SEAM(PH_MOEUP);

    if (IN(PH_MOEDN)) { PHASE_PTRS();
        const int ntiles = __builtin_amdgcn_readfirstlane(tile_e[159]);
        pg8::GemmDesc g{HMOE, W_MDN, FE / 2, FE / 2, FE / 2, 0x79797979, 0x7d7d7d7d}; pg8::MoeOrder S{ntiles, DM / 256, ntiles * (DM / 256), F.G, F.blk, FE / 2, FE / 2, (size_t)DM * FE / 2, tile_e, PERM, false};
        pg8::EpiScatter E{YMOE, DEST}; pg8::gemm_phase<pg8::EpiScatter, pg8::MoeOrder, true, false, 1>(F.lds, g, S, E, tid);
    }
    SEAM(PH_MOEDN);
    if (IN(PH_FINAL)) { PHASE_PTRS();
        const float* gf = AIN(I_FNORM);
        for (int m = gw; m < M; m += NGW) {
            const res_t* xr = XR + (size_t)m * DM; f32x4* orow = (f32x4*)(A_->out + (size_t)m * DM) + lane; const u32x2* y0 = (const u32x2*)(YMOE + (size_t)(2 * m) * DM) + lane; const u32x2* y1 = (const u32x2*)(YMOE + (size_t)(2 * m + 1) * DM) + lane;
            f32x4 v[8]; float s = 0.f;
#pragma unroll
            for (int j = 0; j < 8; ++j) { const u32x2 a = y0[64 * j], b = y1[64 * j]; f32x4 t = ldres4(xr + 4 * (lane + 64 * j));
                t[0] += bflo(a.x) + bflo(b.x); t[1] += bfhi(a.x) + bfhi(b.x); t[2] += bflo(a.y) + bflo(b.y); t[3] += bfhi(a.y) + bfhi(b.y); v[j] = t;
                s += (t[0] * t[0] + t[1] * t[1]) + (t[2] * t[2] + t[3] * t[3]); }
            const float rstd = 1.0f / sqrtf(wave_sum(s) * (1.f / DM) + EPS); const f32x4* gr = (const f32x4*)gf + lane;
#pragma unroll
            for (int j = 0; j < 8; ++j) orow[64 * j] = v[j] * rstd * gr[64 * j];
        }
    }
#undef IN
#undef SEAM
}

extern "C" void kernel_launch(void* const* d_in, const int* in_sizes, int n_in, void* d_out, int out_size, void* d_ws, size_t ws_size, hipStream_t stream) {
    static int grid = 0;
    if (grid == 0) {
        if (n_in != 22 || in_sizes[0] != M * DM || out_size != M * DM || ws_size < WS_END) { fprintf(stderr, "kernel_launch: unexpected shapes / workspace (n_in %d, ws %zu, need %zu)\n", n_in, ws_size, (size_t)WS_END); grid = -1; return; }
        int dev = 0, cus = 0;
        if (hipGetDevice(&dev) != hipSuccess || hipDeviceGetAttribute(&cus, hipDeviceAttributeMultiprocessorCount, dev) != hipSuccess) { grid = -1; return; }
        if (hipFuncSetAttribute((const void*)fwd_kernel, hipFuncAttributeMaxDynamicSharedMemorySize, LDS_BYTES) != hipSuccess) { fprintf(stderr, "kernel_launch: hipFuncSetAttribute failed\n"); grid = -1; return; }
        int per_cu = 0; (void)hipOccupancyMaxActiveBlocksPerMultiprocessor(&per_cu, (const void*)fwd_kernel, NTHREADS, LDS_BYTES); (void)hipGetLastError();
        if (per_cu < 1) fprintf(stderr, "kernel_launch: occupancy query reports %d blocks per CU\n", per_cu);
        grid = cus;
    }
    if (grid < 0) return;
    (void)hipMemsetAsync((char*)d_ws + WS_CTL, 0, CTL_ZERO_BYTES, stream);
    Args a{};
    for (int i = 0; i < 22; ++i) a.in[i] = (const float*)d_in[i];
    a.out = (float*)d_out; a.ws = (unsigned char*)d_ws;
    for (int k = 0; k < 32; ++k) a.inv_freq[k] = (float)pow(10000.0, -(double)(2 * k) / 64.0);
#ifndef MAX_PHASE
#define MAX_PHASE NPH
#endif
#if MK_PER_PHASE
    for (int ph = 0; ph < MAX_PHASE; ++ph) { a.ph_lo = ph; a.ph_hi = ph + 1; hipLaunchKernelGGL(fwd_kernel, dim3(grid), dim3(NTHREADS), LDS_BYTES, stream, a);
        if ((PROBE_MASK >> ph) & 1) hipLaunchKernelGGL(fwd_kernel, dim3(grid), dim3(NTHREADS), LDS_BYTES, stream, a); }
#else
    a.ph_lo = 0; a.ph_hi = NPH; hipLaunchKernelGGL(fwd_kernel, dim3(grid), dim3(NTHREADS), LDS_BYTES, stream, a);
#endif
}
```

```cpp
#include <hip/hip_runtime.h>
#include <cstdio>
#include <cstdint>
#include <cmath>

#ifndef MK_PER_PHASE
#define MK_PER_PHASE 0
#endif
#ifndef PROBE_MASK
#define PROBE_MASK 0
#endif
#ifndef OVERLAP_CONV
#define OVERLAP_CONV 1
#endif
#ifndef FFN_UP_FP8
#define FFN_UP_FP8 0
#endif
#ifndef FFN_UP_I8
#define FFN_UP_I8 1
#endif
#ifndef RES_BF16
#define RES_BF16 1
#endif
#ifndef I8_PERCOL
#define I8_PERCOL 1
#endif
#ifndef FOLD_QKV_NORM
#define FOLD_QKV_NORM 1
#endif
#ifndef BUF_DMA
#define BUF_DMA 1
#endif
#ifndef RELAX_FIRST
#define RELAX_FIRST 1
#endif
#ifndef FUSE_NORM1
#define FUSE_NORM1 1
#endif
#ifndef FFN_DN_FP8
#define FFN_DN_FP8 1
#endif

#define LAS __attribute__((address_space(3)))
#define GAS __attribute__((address_space(1)))
typedef unsigned short bf16_t;
typedef short bf16x8 __attribute__((ext_vector_type(8)));
typedef short s16x4 __attribute__((ext_vector_type(4)));
typedef float f32x2 __attribute__((ext_vector_type(2)));
typedef float f32x4 __attribute__((ext_vector_type(4)));
typedef float f32x16 __attribute__((ext_vector_type(16)));
typedef unsigned u32x2 __attribute__((ext_vector_type(2)));
typedef unsigned u32x4 __attribute__((ext_vector_type(4)));
typedef int i32x4 __attribute__((ext_vector_type(4)));
typedef int i32x8 __attribute__((ext_vector_type(8)));

constexpr int DM = 2048, SEQ = 4096, M = 16384;
constexpr int CONV = 1024, NH = 8, QLORA = 512, KVLORA = 256, QKD = 192;
constexpr int INC = 3904, INP = 4096;
constexpr int FF = 5632, NE = 8, FE = 2816;
constexpr int MOE_ROWS = 2 * M + NE * 256;
constexpr int MOE_TILES = MOE_ROWS / 256;
constexpr float EPS = 1e-6f;
constexpr float QSCALE = 0.07216878364870322f * 1.4426950408889634f;
constexpr int NWAVES = 8, NTHREADS = 512;

constexpr size_t MiB = 1u << 20;
constexpr size_t WS_CTL = 0, CTL_ZERO_BYTES = 1 * MiB;
constexpr size_t WS_ROPE = 1 * MiB;
constexpr size_t WS_MISC = 2 * MiB;
constexpr size_t WS_W_IN = 4 * MiB;
constexpr size_t WS_W_UQ = WS_W_IN + 16 * MiB;
constexpr size_t WS_W_UKV = WS_W_UQ + 2 * MiB;
constexpr size_t WS_W_OUT = WS_W_UKV + 1 * MiB;
constexpr size_t WS_W_GU = WS_W_OUT + 8 * MiB;
constexpr size_t WS_W_DN = WS_W_GU + 44 * MiB;
constexpr size_t WS_W_POOL = WS_W_DN + 22 * MiB;
constexpr size_t WS_W_MGU = WS_W_POOL + 2 * MiB;
constexpr size_t WS_W_MDN = WS_W_MGU + 88 * MiB;
constexpr size_t WS_XBA = WS_W_MDN + 44 * MiB;
constexpr size_t WS_XBB = WS_XBA + 64 * MiB;
constexpr size_t WS_R0 = WS_XBB + 64 * MiB;
constexpr size_t WS_PROJ = WS_R0;
constexpr size_t WS_Q = WS_R0 + 220 * MiB;
constexpr size_t WS_KN = WS_R0 + 268 * MiB;
constexpr size_t WS_CQ = WS_R0 + 96 * MiB;
constexpr size_t WS_CKV = WS_R0 + 112 * MiB;
constexpr size_t WS_KR = WS_R0 + 120 * MiB;
constexpr size_t WS_V = WS_R0 + 124 * MiB;
constexpr size_t WS_YAB = WS_R0 + 156 * MiB;
constexpr size_t WS_H = WS_R0;
constexpr size_t WS_HMOE = WS_R0;
constexpr size_t WS_YMOE = WS_R0 + 188 * MiB;
constexpr size_t WS_SSQ = WS_R0 + 316 * MiB;
constexpr size_t WS_XRB = WS_SSQ + 2 * MiB;
constexpr size_t WS_ST4 = WS_XRB + 64 * MiB;
constexpr size_t WS_END = WS_ST4 + 4 * MiB;
constexpr size_t MS_TOPI = 0, MS_TOPP = 128 * 1024, MS_CNT = 256 * 1024, MS_PERM = 272 * 1024, MS_GATE = 416 * 1024, MS_DEST = 560 * 1024, MS_TILE = 704 * 1024;
constexpr int CW_P4 = 12288;
constexpr int CW_BAR = 4096, CW_DIAG = 16384, CW_WMAX = 8192;
constexpr size_t MS_SSQ2 = 1024 * 1024;
constexpr size_t MS_WSC = 832 * 1024;
constexpr size_t MS_ASC = 768 * 1024;

constexpr int RING_BYTES = 131072;
constexpr int LX_BAR = RING_BYTES;
constexpr int LX_TILE = RING_BYTES + 256;
constexpr int LDS_BYTES = 147456;

__device__ __forceinline__ unsigned cvt_pk_bf16(float lo, float hi) { unsigned r; asm volatile("v_cvt_pk_bf16_f32 %0, %1, %2" : "=v"(r) : "v"(lo), "v"(hi)); return r; }
__device__ __forceinline__ float bf2f(unsigned short b) { return __uint_as_float((unsigned)b << 16); }
__device__ __forceinline__ float bflo(unsigned w) { return __uint_as_float(w << 16); }
__device__ __forceinline__ float bfhi(unsigned w) { return __uint_as_float(w & 0xffff0000u); }
__device__ __forceinline__ float wave_sum(float v) {
#pragma unroll
    for (int o = 1; o < 64; o <<= 1) v += __shfl_xor(v, o);
    return v;
}
__device__ __forceinline__ u32x4 pack8(f32x4 a, f32x4 b) { u32x4 w; w.x = cvt_pk_bf16(a[0], a[1]); w.y = cvt_pk_bf16(a[2], a[3]); w.z = cvt_pk_bf16(b[0], b[1]); w.w = cvt_pk_bf16(b[2], b[3]); return w; }
#if RES_BF16
typedef bf16_t res_t;
#else
typedef float res_t;
#endif
__device__ __forceinline__ f32x4 ldrow4(const float* p) { return *(const f32x4*)p; }
__device__ __forceinline__ f32x4 ldrow4(const bf16_t* p) { const u32x2 w = *(const u32x2*)p; return (f32x4){__uint_as_float(w.x << 16), __uint_as_float(w.x & 0xffff0000u), __uint_as_float(w.y << 16), __uint_as_float(w.y & 0xffff0000u)}; }
__device__ __forceinline__ f32x4 ldres4(const res_t* p) {
#if RES_BF16
    const u32x2 w = *(const u32x2*)p; return (f32x4){bflo(w.x), bfhi(w.x), bflo(w.y), bfhi(w.y)};
#else
    return *(const f32x4*)p;
#endif
}
#define LDS_WAIT() asm volatile("s_waitcnt lgkmcnt(0)" ::: "memory")
#define VM_WAIT() asm volatile("s_waitcnt vmcnt(0)" ::: "memory")

namespace pg8 {
constexpr int BM = 256, BK = 64, HALF = 128, HTB = HALF * BK * 2, STAGE_BYTES = 8 * HTB, NXCD = 8, WGM = 8;
__host__ __device__ __forceinline__ int lds_byte(int r, int c) { const int st = (r >> 4) * 2 + (c >> 5), rr = r & 15, cc = c & 31, ob = rr * 64 + cc * 2; return st * 1024 + (ob ^ (((ob >> 9) & 1) << 5)); }
__host__ __device__ __forceinline__ void stage_rc(int b, int& R, int& C) { const int st = b / 1024, sb = b % 1024, swz = sb ^ (((sb >> 9) & 1) << 5); R = (st >> 1) * 16 + swz / 64; C = (st & 1) * 32 + (swz % 64) / 2; }
__host__ __device__ __forceinline__ int perm32(int rho) { const int n = rho >> 4, i = rho & 15; return 8 * (i >> 2) + 4 * n + (i & 3); }

struct Unit { int pm, pn, e; size_t a_off, b_off; const int* rows; };
struct GemmDesc { const bf16_t* A; const bf16_t* Bt; int lda, ldb, K; int sc_w, sc_a; };

__device__ __forceinline__ void order_decode(long L, int nwg, int nM, int nN, int& pm, int& pn, int wgm = WGM) {
    int wgid = (int)L; { const int q = nwg / NXCD, r = nwg % NXCD, xcd = wgid % NXCD, off = wgid / NXCD; wgid = (xcd < r ? xcd * (q + 1) : r * (q + 1) + (xcd - r) * q) + off; }
    const int nig = wgm * nN, gid = wgid / nig, fm = gid * wgm, gsz = (nM - fm) < wgm ? (nM - fm) : wgm;
    pm = fm + ((wgid % nig) % gsz); pn = (wgid % nig) / gsz;
}
struct StaticOrder {
    int nM, nN, nwg, G, c, lda, ldb, grp_div, grp_cols, wgm;
    __device__ __forceinline__ void init(int nM_, int nN_, int G_, int c_, int lda_, int ldb_, int gd = 0, int gc = 0, int wgm_ = WGM) { nM = nM_; nN = nN_; nwg = nM * nN; G = G_; c = c_; lda = lda_; ldb = ldb_; grp_div = gd; grp_cols = gc; wgm = wgm_; }
    __device__ __forceinline__ bool next(int i, Unit& u) const {
        const long L = (long)i * G + c; if (L >= nwg) return false;
        order_decode(L, nwg, nM, nN, u.pm, u.pn, wgm);
        u.a_off = (size_t)u.pm * BM * lda + (grp_div ? (size_t)(u.pn / grp_div) * grp_cols : 0);
        u.b_off = (size_t)u.pn * BM * ldb; u.rows = nullptr; u.e = 0; return true;
    }
};
struct MoeOrder {
    int nM, nN, nwg, G, c, lda, ldb; size_t estride; const LAS int* tile_e; const int* rows_base; bool gather;
    __device__ __forceinline__ bool next(int i, Unit& u) const {
        const long L = (long)i * G + c; if (L >= nwg) return false;
        order_decode(L, nwg, nM, nN, u.pm, u.pn);
        u.e = __builtin_amdgcn_readfirstlane(tile_e[u.pm]);
        u.a_off = gather ? 0 : (size_t)u.pm * BM * lda;
        u.b_off = (size_t)u.e * estride + (size_t)u.pn * BM * ldb; u.rows = rows_base + u.pm * BM; return true;
    }
};

template <class Epi, class Sched, bool ALIGN_EPI, bool GATHER, int MODE = 0>
__device__ __forceinline__ void gemm_phase(LAS unsigned char* lds, const GemmDesc g, const Sched& S, const Epi& E, const int tid) {
    const int wid = __builtin_amdgcn_readfirstlane(tid >> 6), lane = tid & 63, wr = wid >> 2, wc = wid & 3, fr = lane & 15, fq = lane >> 4;
    constexpr bool FP8 = (MODE == 1), I8 = (MODE == 2);
    const int K = g.K, nt = K / BK;
    unsigned voffA[2], voffB[2], ca2[2]; int ra[2];
#pragma unroll
    for (int i = 0; i < 2; ++i) { int R, C; stage_rc(tid * 16 + i * 8192, R, C); const int Rb = Epi::PERM ? ((R & ~31) + perm32(R & 31)) : R;
        voffA[i] = (unsigned)(R * g.lda + C) * 2u; voffB[i] = (unsigned)(Rb * g.ldb + C) * 2u; ra[i] = R; ca2[i] = (unsigned)C * 2u; }
    const size_t kstep = (size_t)(BK * 2);
    const size_t hstepA = (size_t)HALF * g.lda * 2, hstepB = (size_t)HALF * g.ldb * 2;
    const unsigned ldsw = (unsigned)wid * 1024u;
    const int aoff = lds_byte(wr * 64 + fr, fq * 8), boff = lds_byte(wc * 32 + fr, fq * 8);
    unsigned vgC[2][2], vgN[2][2];
#define PG8_SA(b, h) (((b) * 2 + (h)) * HTB)
#define PG8_SB(b, h) ((4 + (b) * 2 + (h)) * HTB)
#if BUF_DMA
    const __amdgpu_buffer_rsrc_t rsA = __builtin_amdgcn_make_buffer_rsrc((void*)g.A, 0, 0x7ffff000, 0x00020000), rsB = __builtin_amdgcn_make_buffer_rsrc((void*)g.Bt, 0, 0x7ffff000, 0x00020000);
#define PG8_BLDS(rs, voff, soff, bufoff, i) __builtin_amdgcn_raw_ptr_buffer_load_lds(rs, (LAS unsigned*)(lds + (bufoff) + ldsw + (i) * 8192), 16, (int)(voff), (int)(soff), 0, 0)
#define PG8_STAGE_B(bufoff, gbase) do { const unsigned so_ = (unsigned)((const char*)(gbase) - (const char*)g.Bt); _Pragma("unroll") for (int _i = 0; _i < 2; ++_i) PG8_BLDS(rsB, voffB[_i], so_, bufoff, _i); } while (0)
#define PG8_STAGE_A(bufoff, gbase, h, nx) do { const unsigned so_ = (unsigned)((const char*)(gbase) - (const char*)g.A) + (GATHER ? 0u : (unsigned)((size_t)(h) * hstepA)); _Pragma("unroll") for (int _i = 0; _i < 2; ++_i) { \
        if constexpr (GATHER) { PG8_BLDS(rsA, ((nx) ? vgN[h][_i] : vgC[h][_i]), so_, bufoff, _i); } \
        else { PG8_BLDS(rsA, voffA[_i], so_, bufoff, _i); } } } while (0)
#else
#define PG8_GLDS(src, bufoff, i) __builtin_amdgcn_global_load_lds((const unsigned*)(src), (LAS unsigned*)(lds + (bufoff) + ldsw + (i) * 8192), 16, 0, 0)
#define PG8_STAGE_B(bufoff, gbase) do { _Pragma("unroll") for (int _i = 0; _i < 2; ++_i) PG8_GLDS((const char*)(gbase) + voffB[_i], bufoff, _i); } while (0)
#define PG8_STAGE_A(bufoff, gbase, h, nx) do { _Pragma("unroll") for (int _i = 0; _i < 2; ++_i) { \
        if constexpr (GATHER) { PG8_GLDS((const char*)(gbase) + ((nx) ? vgN[h][_i] : vgC[h][_i]), bufoff, _i); } \
        else { PG8_GLDS((const char*)(gbase) + (size_t)(h) * hstepA + voffA[_i], bufoff, _i); } } } while (0)
#endif
#define PG8_LDA(b, h) do { _Pragma("unroll") for (int m = 0; m < 4; ++m) { \
        if constexpr (FP8) { const i32x4 lo_ = *(const LAS i32x4*)(lds + PG8_SA(b, h) + aoff + m * 2048), hi_ = *(const LAS i32x4*)(lds + PG8_SA(b, h) + aoff + m * 2048 + 1024); At8[m] = __builtin_shufflevector(lo_, hi_, 0, 1, 2, 3, 4, 5, 6, 7); } \
        else { _Pragma("unroll") for (int k = 0; k < 2; ++k) At[m][k] = *(const LAS bf16x8*)(lds + PG8_SA(b, h) + aoff + m * 2048 + k * 1024); } } } while (0)
#define PG8_LDB(W, b, h) do { _Pragma("unroll") for (int n = 0; n < 2; ++n) { \
        if constexpr (FP8) { const i32x4 lo_ = *(const LAS i32x4*)(lds + PG8_SB(b, h) + boff + n * 2048), hi_ = *(const LAS i32x4*)(lds + PG8_SB(b, h) + boff + n * 2048 + 1024); B8[W][n] = __builtin_shufflevector(lo_, hi_, 0, 1, 2, 3, 4, 5, 6, 7); } \
        else { _Pragma("unroll") for (int k = 0; k < 2; ++k) Bq[W][n][k] = *(const LAS bf16x8*)(lds + PG8_SB(b, h) + boff + n * 2048 + k * 1024); } } } while (0)
#define PG8_MMA(ai, bj) do { __builtin_amdgcn_s_setprio(1); _Pragma("unroll") for (int m = 0; m < 4; ++m) _Pragma("unroll") for (int n = 0; n < 2; ++n) { \
        if constexpr (FP8) { asm volatile("v_mfma_scale_f32_16x16x128_f8f6f4 %0, %1, %2, %0, %3, %4 op_sel_hi:[0,0,0]" : "+v"(acc[ai][bj][m][n]) : "v"(B8[bj][n]), "v"(At8[m]), "v"(scw), "v"(sca)); } \
        else if constexpr (I8) { _Pragma("unroll") for (int k = 0; k < 2; ++k) acc[ai][bj][m][n] = __builtin_bit_cast(f32x4, __builtin_amdgcn_mfma_i32_16x16x64_i8(__builtin_bit_cast(i32x4, Bq[bj][n][k]), __builtin_bit_cast(i32x4, At[m][k]), __builtin_bit_cast(i32x4, acc[ai][bj][m][n]), 0, 0, 0)); } \
        else { _Pragma("unroll") for (int k = 0; k < 2; ++k) acc[ai][bj][m][n] = __builtin_amdgcn_mfma_f32_16x16x32_bf16(Bq[bj][n][k], At[m][k], acc[ai][bj][m][n], 0, 0, 0); } } \
        __builtin_amdgcn_s_setprio(0); } while (0)
#define PG8_WAIT_V(n) asm volatile("s_waitcnt vmcnt(" #n ")" ::: "memory")
#define PG8_WAIT_L(n) asm volatile("s_waitcnt lgkmcnt(" #n ")" ::: "memory")
#define PG8_WAIT_V8F(first) do { if (RELAX_FIRST && Epi::NST > 0 && (first)) asm volatile("s_waitcnt vmcnt(%0)" :: "n"(8 + Epi::NST) : "memory"); else asm volatile("s_waitcnt vmcnt(8)" ::: "memory"); } while (0)
#define PG8_BAR __builtin_amdgcn_s_barrier()
#define PG8_SCHED __builtin_amdgcn_sched_barrier(0)
#define PG8_VG(dst, u) do { _Pragma("unroll") for (int _h = 0; _h < 2; ++_h) _Pragma("unroll") for (int _i = 0; _i < 2; ++_i) dst[_h][_i] = (unsigned)(u).rows[_h * HALF + ra[_i]] * (unsigned)(g.lda * 2) + ca2[_i]; } while (0)
    Unit cur, nxt; int ui = 0;
    if (!S.next(0, cur)) return;
    const int scw = g.sc_w, sca = g.sc_a; (void)scw; (void)sca;
    f32x4 acc[2][2][4][2];
#pragma unroll
    for (int a = 0; a < 2; ++a)
#pragma unroll
        for (int b = 0; b < 2; ++b)
#pragma unroll
            for (int m = 0; m < 4; ++m)
#pragma unroll
                for (int n = 0; n < 2; ++n) acc[a][b][m][n] = (f32x4){0.f, 0.f, 0.f, 0.f};
    bf16x8 At[4][2], Bq[2][2][2]; i32x8 At8[4], B8[2][2]; (void)At; (void)Bq; (void)At8; (void)B8;
    const char* cA = (const char*)g.A + cur.a_off * 2; const char* cB = (const char*)g.Bt + cur.b_off * 2;
    if constexpr (GATHER) { PG8_VG(vgC, cur); PG8_VG(vgN, cur); }
    PG8_STAGE_B(PG8_SB(0, 0), cB); PG8_STAGE_B(PG8_SB(0, 1), cB + hstepB); PG8_STAGE_A(PG8_SA(0, 0), cA, 0, false); PG8_STAGE_A(PG8_SA(0, 1), cA, 1, false);
    if (wr == 1) PG8_BAR;
    PG8_WAIT_V(2); PG8_BAR;
    PG8_STAGE_B(PG8_SB(1, 0), cB + kstep); PG8_STAGE_A(PG8_SA(1, 0), cA + kstep, 0, false); PG8_STAGE_B(PG8_SB(1, 1), cB + hstepB + kstep);
    PG8_WAIT_V(6); PG8_BAR;
    for (;;) {
        const bool has_next = S.next(ui + 1, nxt);
        const char* nA = has_next ? (const char*)g.A + nxt.a_off * 2 : cA; const char* nB = has_next ? (const char*)g.Bt + nxt.b_off * 2 : cB;
        if constexpr (GATHER) { if (has_next) { PG8_VG(vgN, nxt); } else {
#pragma unroll
            for (int _h = 0; _h < 2; ++_h) { vgN[_h][0] = vgC[_h][0]; vgN[_h][1] = vgC[_h][1]; } } }
        for (int t = 0; t < nt; t += 2) {
            const bool last = (t == nt - 2);
            const char* a1 = cA + (size_t)(t + 1) * kstep;
            const char* a2 = last ? nA : cA + (size_t)(t + 2) * kstep; const char* b2 = last ? nB : cB + (size_t)(t + 2) * kstep;
            const char* a3 = a2 + kstep; const char* b3 = b2 + kstep;
            const bool first_ = (t == 0) && (ui > 0);
            PG8_LDB(0, 0, 0); PG8_LDB(1, 0, 1); PG8_SCHED; PG8_LDA(0, 0); PG8_STAGE_A(PG8_SA(1, 1), a1, 1, false);
            PG8_WAIT_V8F(first_); PG8_WAIT_L(0); PG8_BAR; PG8_MMA(0, 0); PG8_MMA(0, 1); PG8_BAR; PG8_SCHED;
            PG8_LDA(0, 1); PG8_STAGE_B(PG8_SB(0, 0), b2); PG8_STAGE_B(PG8_SB(0, 1), b2 + hstepB); PG8_STAGE_A(PG8_SA(0, 0), a2, 0, last);
            PG8_WAIT_V8F(first_); PG8_WAIT_L(0); PG8_BAR; PG8_MMA(1, 0); PG8_MMA(1, 1); PG8_BAR; PG8_SCHED;
            PG8_LDB(0, 1, 0); PG8_LDB(1, 1, 1); PG8_SCHED; PG8_LDA(1, 0); PG8_STAGE_A(PG8_SA(0, 1), a2, 1, last);
            PG8_WAIT_V(8); PG8_WAIT_L(0); PG8_BAR; PG8_MMA(0, 0); PG8_MMA(0, 1); PG8_BAR; PG8_SCHED;
            PG8_LDA(1, 1); PG8_STAGE_B(PG8_SB(1, 0), b3); PG8_STAGE_B(PG8_SB(1, 1), b3 + hstepB); PG8_STAGE_A(PG8_SA(1, 0), a3, 0, last);
            PG8_WAIT_V(8); PG8_WAIT_L(0); PG8_BAR; PG8_MMA(1, 0); PG8_MMA(1, 1); PG8_BAR; PG8_SCHED;
        }
        if constexpr (ALIGN_EPI) { if (wr == 0) PG8_BAR; }
        if constexpr (FP8) asm volatile("s_nop 15\n\ts_nop 15" ::: "memory");
        if constexpr (I8) {
#pragma unroll
            for (int a = 0; a < 2; ++a)
#pragma unroll
                for (int b = 0; b < 2; ++b)
#pragma unroll
                    for (int m = 0; m < 4; ++m)
#pragma unroll
                        for (int n = 0; n < 2; ++n) acc[a][b][m][n] = __builtin_convertvector(__builtin_bit_cast(i32x4, acc[a][b][m][n]), f32x4); }
        E(acc, cur, wr, wc, fr, fq);
        if (!has_next) break;
#pragma unroll
        for (int a = 0; a < 2; ++a)
#pragma unroll
            for (int b = 0; b < 2; ++b)
#pragma unroll
                for (int m = 0; m < 4; ++m)
#pragma unroll
                    for (int n = 0; n < 2; ++n) acc[a][b][m][n] = (f32x4){0.f, 0.f, 0.f, 0.f};
        cur = nxt; cA = nA; cB = nB; ++ui;
        if constexpr (GATHER) {
#pragma unroll
            for (int _h = 0; _h < 2; ++_h) { vgC[_h][0] = vgN[_h][0]; vgC[_h][1] = vgN[_h][1]; } }
        if constexpr (ALIGN_EPI) { if (wr == 1) PG8_BAR; }
    }
    PG8_WAIT_V(0);
    if constexpr (!ALIGN_EPI) { if (wr == 0) PG8_BAR; }
    PG8_BAR;
#undef PG8_SA
#undef PG8_SB
#if BUF_DMA
#undef PG8_BLDS
#else
#undef PG8_GLDS
#endif
#undef PG8_STAGE_A
#undef PG8_STAGE_B
#undef PG8_LDA
#undef PG8_LDB
#undef PG8_MMA
#undef PG8_WAIT_V
#undef PG8_WAIT_L
#undef PG8_WAIT_V8F
#undef PG8_BAR
#undef PG8_SCHED
#undef PG8_VG
}

typedef f32x4 AccT[2][2][4][2];
struct EpiProj {
    static constexpr bool PERM = true; static constexpr int NST = 0;
    bf16_t* PROJ; bf16_t* CQ; bf16_t* CKV; bf16_t* KR; const float* rope; float* ssq2;
    __device__ __forceinline__ void operator()(const AccT& acc, const Unit& u, int wr, int wc, int fr, int fq) const {
        const int row0 = u.pm * BM + wr * 64 + fr;
        if (ssq2 && u.pn >= 12 && u.pn < 15) {
#pragma unroll
            for (int ai = 0; ai < 2; ++ai)
#pragma unroll
                for (int m = 0; m < 4; ++m) { float q = 0.f;
#pragma unroll
                    for (int bj = 0; bj < 2; ++bj)
#pragma unroll
                        for (int n = 0; n < 2; ++n) { const f32x4 v = acc[ai][bj][m][n]; q += (v[0] * v[0] + v[1] * v[1]) + (v[2] * v[2] + v[3] * v[3]); }
                    q += __shfl_xor(q, 16); q += __shfl_xor(q, 32);
                    if (fq == 0) ssq2[(size_t)(row0 + ai * HALF + m * 16) * 12 + (u.pn - 12) * 4 + wc] = q; } }
        if (u.pn < 15) {
            bf16_t* base; int ld, colt;
            if (u.pn < 12) { base = PROJ; ld = 3072; colt = u.pn * 256; } else if (u.pn < 14) { base = CQ; ld = 512; colt = (u.pn - 12) * 256; } else { base = CKV; ld = 256; colt = 0; }
            const int col0 = colt + wc * 32 + 8 * fq;
#pragma unroll
            for (int ai = 0; ai < 2; ++ai)
#pragma unroll
                for (int m = 0; m < 4; ++m) { bf16_t* rowp = base + (size_t)(row0 + ai * HALF + m * 16) * ld + col0;
#pragma unroll
                    for (int bj = 0; bj < 2; ++bj) *(u32x4*)(rowp + bj * HALF) = pack8(acc[ai][bj][m][0], acc[ai][bj][m][1]); }
        } else if (wc < 2) {
            const int c0 = wc * 32 + 8 * fq, i0 = c0 >> 1;
#pragma unroll
            for (int ai = 0; ai < 2; ++ai)
#pragma unroll
                for (int m = 0; m < 4; ++m) { const int row = row0 + ai * HALF + m * 16; const float* rp = rope + (size_t)(row & (SEQ - 1)) * 64 + i0;
                    const f32x4 cs = *(const f32x4*)rp, sn = *(const f32x4*)(rp + 32); const f32x4 v0 = acc[ai][0][m][0], v1 = acc[ai][0][m][1];
                    f32x4 o0, o1;
                    o0[0] = v0[0] * cs[0] - v0[1] * sn[0]; o0[1] = v0[0] * sn[0] + v0[1] * cs[0]; o0[2] = v0[2] * cs[1] - v0[3] * sn[1]; o0[3] = v0[2] * sn[1] + v0[3] * cs[1];
                    o1[0] = v1[0] * cs[2] - v1[1] * sn[2]; o1[1] = v1[0] * sn[2] + v1[1] * cs[2]; o1[2] = v1[2] * cs[3] - v1[3] * sn[3]; o1[3] = v1[2] * sn[3] + v1[3] * cs[3];
                    *(u32x4*)(KR + (size_t)row * 64 + c0) = pack8(o0, o1); }
        }
    }
};
struct EpiQ {
    static constexpr bool PERM = true; static constexpr int NST = 0;
    bf16_t* Q; const float* rope; const float* ssq2;
    __device__ __forceinline__ void operator()(const AccT& acc, const Unit& u, int wr, int wc, int fr, int fq) const {
        const int row0 = u.pm * BM + wr * 64 + fr;
#pragma unroll
        for (int ai = 0; ai < 2; ++ai)
#pragma unroll
            for (int m = 0; m < 4; ++m) { const int row = row0 + ai * HALF + m * 16; float sc = QSCALE;
                if (ssq2) { const float* p = ssq2 + (size_t)row * 12; const f32x4 a = *(const f32x4*)p, b = *(const f32x4*)(p + 4);
                    sc = QSCALE / sqrtf((((a[0] + a[1]) + (a[2] + a[3])) + ((b[0] + b[1]) + (b[2] + b[3]))) * (1.f / QLORA) + EPS); }
#pragma unroll
                for (int bj = 0; bj < 2; ++bj) { const int c = u.pn * 256 + bj * HALF + wc * 32 + 8 * fq, d = c % QKD; const bool isr = d >= 128; const int i0 = isr ? ((d - 128) >> 1) : 0;
                    f32x4 v0 = acc[ai][bj][m][0] * sc, v1 = acc[ai][bj][m][1] * sc;
                    if (isr) { const float* rp = rope + (size_t)(row & (SEQ - 1)) * 64 + i0; const f32x4 cs = *(const f32x4*)rp, sn = *(const f32x4*)(rp + 32); f32x4 o0, o1;
                        o0[0] = v0[0] * cs[0] - v0[1] * sn[0]; o0[1] = v0[0] * sn[0] + v0[1] * cs[0]; o0[2] = v0[2] * cs[1] - v0[3] * sn[1]; o0[3] = v0[2] * sn[1] + v0[3] * cs[1];
                        o1[0] = v1[0] * cs[2] - v1[1] * sn[2]; o1[1] = v1[0] * sn[2] + v1[1] * cs[2]; o1[2] = v1[2] * cs[3] - v1[3] * sn[3]; o1[3] = v1[2] * sn[3] + v1[3] * cs[3]; v0 = o0; v1 = o1; }
                    *(u32x4*)(Q + (size_t)row * 1536 + c) = pack8(v0, v1); }
                if (m & 1) asm volatile("" ::: "memory"); }
    }
};
struct EpiKV {
    static constexpr bool PERM = true; static constexpr int NST = 0;
    bf16_t* KN; bf16_t* V; const float* ssq2;
    __device__ __forceinline__ void operator()(const AccT& acc, const Unit& u, int wr, int wc, int fr, int fq) const {
        const int row0 = u.pm * BM + wr * 64 + fr, col0 = u.pn * 128 + wc * 32 + 8 * fq;
#pragma unroll
        for (int ai = 0; ai < 2; ++ai)
#pragma unroll
            for (int m = 0; m < 4; ++m) { const int row = row0 + ai * HALF + m * 16; const size_t off = (size_t)row * 1024 + col0; float rs = 1.f;
                if (ssq2) { const f32x4 a = *(const f32x4*)(ssq2 + (size_t)row * 12 + 8); rs = 1.0f / sqrtf(((a[0] + a[1]) + (a[2] + a[3])) * (1.f / KVLORA) + EPS); }
                *(u32x4*)(KN + off) = pack8(acc[ai][0][m][0] * rs, acc[ai][0][m][1] * rs); *(u32x4*)(V + off) = pack8(acc[ai][1][m][0] * rs, acc[ai][1][m][1] * rs); }
    }
};
template <bool SSQ> struct EpiRes {
    static constexpr bool PERM = false; static constexpr int NST = 16;
    const float* base; float* out; const float* scale; float* ssq;
    __device__ __forceinline__ void operator()(const AccT& acc, const Unit& u, int wr, int wc, int fr, int fq) const {
        const int col0 = u.pn * BM + wc * 32 + 4 * fq; f32x4 sv[2][2];
#pragma unroll
        for (int bj = 0; bj < 2; ++bj)
#pragma unroll
            for (int n = 0; n < 2; ++n) sv[bj][n] = scale ? *(const f32x4*)(scale + col0 + bj * HALF + n * 16) : (f32x4){1.f, 1.f, 1.f, 1.f};
#pragma unroll
        for (int ai = 0; ai < 2; ++ai)
#pragma unroll
            for (int m = 0; m < 4; ++m) { const int row = u.pm * BM + ai * HALF + wr * 64 + m * 16 + fr; const size_t off = (size_t)row * DM + col0; float q = 0.f;
#pragma unroll
                for (int bj = 0; bj < 2; ++bj)
#pragma unroll
                    for (int n = 0; n < 2; ++n) { const f32x4 bs = *(const f32x4*)(base + off + bj * HALF + n * 16); const f32x4 o = bs + acc[ai][bj][m][n] * sv[bj][n]; *(f32x4*)(out + off + bj * HALF + n * 16) = o;
                        if constexpr (SSQ) q += (o[0] * o[0] + o[1] * o[1]) + (o[2] * o[2] + o[3] * o[3]); }
                if constexpr (SSQ) { q += __shfl_xor(q, 16); q += __shfl_xor(q, 32); if (fq == 0) ssq[(size_t)row * 32 + u.pn * 4 + wc] = q; }
                if (m & 1) asm volatile("" ::: "memory"); }
    }
};
template <bool SSQ, bool BASE_F32> struct EpiResB {
    static constexpr bool PERM = true; static constexpr int NST = 16;
    const void* base; bf16_t* out; const float* scale; float* ssq;
    __device__ __forceinline__ void operator()(const AccT& acc, const Unit& u, int wr, int wc, int fr, int fq) const {
        const int col0 = u.pn * BM + wc * 32 + 8 * fq; f32x4 sv[2][2];
#pragma unroll
        for (int bj = 0; bj < 2; ++bj)
#pragma unroll
            for (int n = 0; n < 2; ++n) sv[bj][n] = scale ? *(const f32x4*)(scale + col0 + bj * HALF + n * 4) : (f32x4){1.f, 1.f, 1.f, 1.f};
#pragma unroll
        for (int ai = 0; ai < 2; ++ai)
#pragma unroll
            for (int m = 0; m < 4; ++m) { const int row = u.pm * BM + ai * HALF + wr * 64 + m * 16 + fr; const size_t off = (size_t)row * DM + col0; float q = 0.f;
#pragma unroll
                for (int bj = 0; bj < 2; ++bj) { f32x4 b0, b1;
                    if constexpr (BASE_F32) { b0 = *(const f32x4*)((const float*)base + off + bj * HALF); b1 = *(const f32x4*)((const float*)base + off + bj * HALF + 4); }
                    else { const u32x4 w = *(const u32x4*)((const bf16_t*)base + off + bj * HALF); b0 = (f32x4){bflo(w.x), bfhi(w.x), bflo(w.y), bfhi(w.y)}; b1 = (f32x4){bflo(w.z), bfhi(w.z), bflo(w.w), bfhi(w.w)}; }
                    const f32x4 o0 = b0 + acc[ai][bj][m][0] * sv[bj][0], o1 = b1 + acc[ai][bj][m][1] * sv[bj][1];
                    *(u32x4*)(out + off + bj * HALF) = pack8(o0, o1);
                    if constexpr (SSQ) q += ((o0[0] * o0[0] + o0[1] * o0[1]) + (o0[2] * o0[2] + o0[3] * o0[3])) + ((o1[0] * o1[0] + o1[1] * o1[1]) + (o1[2] * o1[2] + o1[3] * o1[3])); }
                if constexpr (SSQ) { q += __shfl_xor(q, 16); q += __shfl_xor(q, 32); if (fq == 0) ssq[(size_t)row * 32 + u.pn * 4 + wc] = q; }
                if (m & 1) asm volatile("" ::: "memory"); }
    }
};
struct EpiResNorm {
    static constexpr bool PERM = true; static constexpr int NST = 0;
    const float* base; bf16_t* out; const float* gain; unsigned char* q8; float* asc; float* stat; unsigned* cnt;
    __device__ __forceinline__ void operator()(AccT& acc, const Unit& u, int wr, int wc, int fr, int fq) const {
        const int col0 = u.pn * BM + wc * 32 + 8 * fq; f32x4 gv[2][2];
#pragma unroll
        for (int bj = 0; bj < 2; ++bj)
#pragma unroll
            for (int n = 0; n < 2; ++n) gv[bj][n] = *(const f32x4*)(gain + col0 + bj * HALF + n * 4);
        float* SQ = stat; float* AM = stat + (size_t)M * 32;
#pragma unroll
        for (int ai = 0; ai < 2; ++ai)
#pragma unroll
            for (int m = 0; m < 4; ++m) { const int row = u.pm * BM + ai * HALF + wr * 64 + m * 16 + fr; const size_t off = (size_t)row * DM + col0; float q = 0.f, a = 0.f;
#pragma unroll
                for (int bj = 0; bj < 2; ++bj) { const f32x4 b0 = *(const f32x4*)(base + off + bj * HALF), b1 = *(const f32x4*)(base + off + bj * HALF + 4);
                    const u32x4 w = pack8(b0 + acc[ai][bj][m][0], b1 + acc[ai][bj][m][1]);
                    *(u32x4*)(out + off + bj * HALF) = w;
                    const f32x4 r0 = {bflo(w.x), bfhi(w.x), bflo(w.y), bfhi(w.y)}, r1 = {bflo(w.z), bfhi(w.z), bflo(w.w), bfhi(w.w)};
                    q += ((r0[0] * r0[0] + r0[1] * r0[1]) + (r0[2] * r0[2] + r0[3] * r0[3])) + ((r1[0] * r1[0] + r1[1] * r1[1]) + (r1[2] * r1[2] + r1[3] * r1[3]));
                    const f32x4 y0 = r0 * gv[bj][0], y1 = r1 * gv[bj][1];
                    a = fmaxf(a, fmaxf(fmaxf(fmaxf(fabsf(y0[0]), fabsf(y0[1])), fmaxf(fabsf(y0[2]), fabsf(y0[3]))), fmaxf(fmaxf(fabsf(y1[0]), fabsf(y1[1])), fmaxf(fabsf(y1[2]), fabsf(y1[3])))));
                    acc[ai][bj][m][0] = y0; acc[ai][bj][m][1] = y1; }
                q += __shfl_xor(q, 16); q += __shfl_xor(q, 32); a = fmaxf(a, __shfl_xor(a, 16)); a = fmaxf(a, __shfl_xor(a, 32));
                if (fq == 0) { __hip_atomic_store(SQ + (size_t)row * 32 + u.pn * 4 + wc, q, __ATOMIC_RELAXED, __HIP_MEMORY_SCOPE_AGENT); __hip_atomic_store(AM + (size_t)row * 32 + u.pn * 4 + wc, a, __ATOMIC_RELAXED, __HIP_MEMORY_SCOPE_AGENT); }
                if (m & 1) asm volatile("" ::: "memory"); }
        asm volatile("s_waitcnt vmcnt(0)" ::: "memory");
        unsigned* c = cnt + u.pm * 32;
        if (fr == 0 && fq == 0) __hip_atomic_fetch_add(c, 1u, __ATOMIC_RELAXED, __HIP_MEMORY_SCOPE_AGENT);
        __builtin_amdgcn_s_barrier();
        if (wr == 0 && wc == 0) { unsigned sp = 0u;
            while (__builtin_amdgcn_readfirstlane(__hip_atomic_load(c, __ATOMIC_RELAXED, __HIP_MEMORY_SCOPE_AGENT)) < 64u) { __builtin_amdgcn_s_sleep(4); if (++sp > (1u << 20)) break; }
            __builtin_amdgcn_fence(__ATOMIC_ACQUIRE, "agent"); asm volatile("s_waitcnt vmcnt(0)" ::: "memory"); }
        __builtin_amdgcn_s_barrier(); asm volatile("" ::: "memory");
#pragma unroll
        for (int ai = 0; ai < 2; ++ai)
#pragma unroll
            for (int m = 0; m < 4; ++m) { const int row = u.pm * BM + ai * HALF + wr * 64 + m * 16 + fr; const float* ps = SQ + (size_t)row * 32 + 8 * fq; const float* pa = AM + (size_t)row * 32 + 8 * fq;
                const f32x4 s0 = *(const f32x4*)ps, s1 = *(const f32x4*)(ps + 4), a0 = *(const f32x4*)pa, a1 = *(const f32x4*)(pa + 4);
                float sq = ((s0[0] + s0[1]) + (s0[2] + s0[3])) + ((s1[0] + s1[1]) + (s1[2] + s1[3])), am = fmaxf(fmaxf(fmaxf(a0[0], a0[1]), fmaxf(a0[2], a0[3])), fmaxf(fmaxf(a1[0], a1[1]), fmaxf(a1[2], a1[3])));
                sq += __shfl_xor(sq, 16); sq += __shfl_xor(sq, 32); am = fmaxf(am, __shfl_xor(am, 16)); am = fmaxf(am, __shfl_xor(am, 32));
                am = fmaxf(am, 1e-20f); const float sc = 127.f / am;
#pragma unroll
                for (int bj = 0; bj < 2; ++bj) { u32x2 w;
#pragma unroll
                    for (int n = 0; n < 2; ++n) { unsigned ww = 0u;
#pragma unroll
                        for (int b = 0; b < 4; ++b) { int qi = __float2int_rn(acc[ai][bj][m][n][b] * sc); qi = qi > 127 ? 127 : (qi < -127 ? -127 : qi); ww |= ((unsigned)qi & 0xffu) << (8 * b); }
                        w[n] = ww; }
                    *(u32x2*)(q8 + (size_t)row * DM + col0 + bj * HALF) = w; }
                if (u.pn == 0 && wc == 0 && fq == 0) asc[row] = am * (1.f / 127.f) / sqrtf(sq * (1.f / DM) + EPS);
                if (m & 1) asm volatile("" ::: "memory"); }
    }
};
template <bool OUT8, bool PRE> struct EpiSwiGLU {
    static constexpr bool PERM = true; static constexpr int NST = 8;
    bf16_t* H; int ldh; const float* rowgate; const float* prerow; float pre; const float* precol;
    __device__ __forceinline__ void operator()(const AccT& acc, const Unit& u, int wr, int wc, int fr, int fq) const {
        const int row0 = u.pm * BM + wr * 64 + fr, col0 = u.pn * 128 + wc * 32 + 8 * fq;
        f32x2 cg2[4], cu2[4];
#pragma unroll
        for (int n = 0; n < 2; ++n) { f32x4 a_ = {1.f, 1.f, 1.f, 1.f}, b_ = {1.f, 1.f, 1.f, 1.f};
            if (PRE && precol) { a_ = *(const f32x4*)(precol + u.pn * 256 + wc * 32 + 8 * fq + 4 * n); b_ = *(const f32x4*)(precol + u.pn * 256 + 128 + wc * 32 + 8 * fq + 4 * n); }
            cg2[2 * n] = (f32x2){a_[0], a_[1]}; cg2[2 * n + 1] = (f32x2){a_[2], a_[3]}; cu2[2 * n] = (f32x2){b_[0], b_[1]}; cu2[2 * n + 1] = (f32x2){b_[2], b_[3]}; }
#pragma unroll
        for (int ai = 0; ai < 2; ++ai)
#pragma unroll
            for (int m = 0; m < 4; ++m) { const int row = row0 + ai * HALF + m * 16; const float rg = rowgate ? rowgate[row] : 1.f; const float ps = (PRE && prerow) ? prerow[row] * pre : 1.f;
                const float R = rg * ps * (OUT8 ? 4.f : 1.f), psl = -1.4426950408889634f * ps; f32x4 o[2];
#pragma unroll
                for (int n = 0; n < 2; ++n)
#pragma unroll
                    for (int h = 0; h < 2; ++h) { const f32x2 ag = {acc[ai][0][m][n][2 * h], acc[ai][0][m][n][2 * h + 1]}, au = {acc[ai][1][m][n][2 * h], acc[ai][1][m][n][2 * h + 1]};
                        f32x2 t = ag, uu = au; if (PRE) { t = ag * cg2[2 * n + h]; uu = au * cu2[2 * n + h]; }
                        const f32x2 gt = PRE ? t * ps : t, ea = t * psl;
                        const f32x2 d = (f32x2){__builtin_amdgcn_exp2f(ea[0]), __builtin_amdgcn_exp2f(ea[1])} + 1.f;
                        const f32x2 r = {__builtin_amdgcn_rcpf(d[0]), __builtin_amdgcn_rcpf(d[1])};
                        const f32x2 ov = (gt * r) * (uu * R); o[n][2 * h] = ov[0]; o[n][2 * h + 1] = ov[1]; }
                if constexpr (OUT8) { u32x2 w; int t;
                    t = __builtin_amdgcn_cvt_pk_fp8_f32(o[0][0], o[0][1], 0, false); t = __builtin_amdgcn_cvt_pk_fp8_f32(o[0][2], o[0][3], t, true); w.x = (unsigned)t;
                    t = __builtin_amdgcn_cvt_pk_fp8_f32(o[1][0], o[1][1], 0, false); t = __builtin_amdgcn_cvt_pk_fp8_f32(o[1][2], o[1][3], t, true); w.y = (unsigned)t;
                    *(u32x2*)((unsigned char*)H + (size_t)row * ldh + col0) = w; }
                else *(u32x4*)(H + (size_t)row * ldh + col0) = pack8(o[0], o[1]); }
    }
};
struct EpiScatter {
    static constexpr bool PERM = true; static constexpr int NST = 0;
    bf16_t* Y; const int* dest;
    __device__ __forceinline__ void operator()(const AccT& acc, const Unit& u, int wr, int wc, int fr, int fq) const {
        const int row0 = u.pm * BM + wr * 64 + fr, col0 = u.pn * 256 + wc * 32 + 8 * fq;
#pragma unroll
        for (int ai = 0; ai < 2; ++ai)
#pragma unroll
            for (int m = 0; m < 4; ++m) { const int d = dest[row0 + ai * HALF + m * 16];
                if (d >= 0) { bf16_t* rowp = Y + (size_t)d * DM + col0;
#pragma unroll
                    for (int bj = 0; bj < 2; ++bj) *(u32x4*)(rowp + bj * HALF) = pack8(acc[ai][bj][m][0], acc[ai][bj][m][1]); } }
    }
};
}

namespace att {
constexpr int KSTR = 400, SHM_K = 64 * KSTR, SHM_V = 16384;
constexpr int OFF_V = 0, OFF_K = 2 * SHM_V, OFF_WS = OFF_K + 2 * SHM_K, ATT_LDS = OFF_WS + NWAVES * 64 * 4;
static_assert(ATT_LDS <= RING_BYTES, "attention LDS");
#define SBAR() __builtin_amdgcn_sched_barrier(0)
__device__ __forceinline__ int v_st(int k, int c) { const int kk = (k & ~0xC) | ((k & 4) << 1) | ((k & 8) >> 1); return ((kk >> 3) * 4 + (c >> 5)) * 512 + ((kk & 7) * 32 + (c & 31)) * 2; }
__device__ __forceinline__ int v_rd_base(int lane) { return ((lane & 3) << 3) | (((lane >> 2) & 3) << 6) | (((lane >> 4) & 1) << 5) | (((lane >> 5) & 1) << 8); }
__device__ __forceinline__ int crow(int r, int hi) { return (r & 3) + 8 * (r >> 2) + 4 * hi; }
__device__ __forceinline__ void mask_tile(f32x16& p0, f32x16& p1, int dq) {
    const float NEG = -__builtin_inff();
#pragma unroll
    for (int r = 0; r < 16; ++r) { const int c = (r & 3) + 8 * (r >> 2); if (c > dq) p0[r] = NEG; if (c + 32 > dq) p1[r] = NEG; }
}
__device__ __forceinline__ void partialSM(f32x16& p0, f32x16& p1, float& m_reg, float& mn, float& alpha) {
    float pmax = p0[0];
#pragma unroll
    for (int r = 1; r < 16; ++r) pmax = fmaxf(pmax, p0[r]);
#pragma unroll
    for (int r = 0; r < 16; ++r) pmax = fmaxf(pmax, p1[r]);
    { auto rr = __builtin_amdgcn_permlane32_swap(__float_as_uint(pmax), __float_as_uint(pmax), false, false); pmax = fmaxf(__uint_as_float(rr[0]), __uint_as_float(rr[1])); }
    if (__builtin_expect(__all((pmax - m_reg) <= 8.f), 1)) { mn = m_reg; alpha = 1.f; }
    else { mn = fmaxf(m_reg, pmax); alpha = __builtin_amdgcn_exp2f(m_reg - mn); m_reg = mn; }
#pragma unroll
    for (int r = 0; r < 16; ++r) p0[r] = __builtin_amdgcn_exp2f(p0[r] - mn);
}
__device__ __forceinline__ void finishSM(f32x16& p0, f32x16& p1, float mn, float alpha, float& l_reg, bf16x8& pa0, bf16x8& pa1, bf16x8& pa2, bf16x8& pa3) {
#pragma unroll
    for (int r = 0; r < 16; ++r) p1[r] = __builtin_amdgcn_exp2f(p1[r] - mn);
    float ps = 0;
#pragma unroll
    for (int r = 0; r < 16; ++r) ps += p0[r];
#pragma unroll
    for (int r = 0; r < 16; ++r) ps += p1[r];
    { auto rr = __builtin_amdgcn_permlane32_swap(__float_as_uint(ps), __float_as_uint(ps), false, false); ps = __uint_as_float(rr[0]) + __uint_as_float(rr[1]); }
    l_reg = l_reg * alpha + ps;
#define PK4(P, B_, OUT) do { unsigned a0 = cvt_pk_bf16(P[B_+0], P[B_+1]), a1 = cvt_pk_bf16(P[B_+2], P[B_+3]); \
        unsigned b0 = cvt_pk_bf16(P[B_+4], P[B_+5]), b1 = cvt_pk_bf16(P[B_+6], P[B_+7]); \
        auto r0 = __builtin_amdgcn_permlane32_swap(a0, b0, false, false); auto r1 = __builtin_amdgcn_permlane32_swap(a1, b1, false, false); \
        u32x4 w = {r0[0], r1[0], r0[1], r1[1]}; OUT = *reinterpret_cast<bf16x8*>(&w); } while (0)
    PK4(p0, 0, pa0); PK4(p0, 8, pa1); PK4(p1, 0, pa2); PK4(p1, 8, pa3);
#undef PK4
}
__device__ __forceinline__ void qkt(f32x16& p0, f32x16& p1, const char* kb, const bf16x8* qr) {
    p0 = f32x16{}; p1 = f32x16{};
#pragma unroll
    for (int g = 0; g < 4; ++g) {
        bf16x8 b0[3], b1[3];
#pragma unroll
        for (int j = 0; j < 3; ++j) { b0[j] = *reinterpret_cast<const bf16x8*>(kb + (g * 3 + j) * 32); b1[j] = *reinterpret_cast<const bf16x8*>(kb + (g * 3 + j) * 32 + 32 * KSTR); }
#pragma unroll
        for (int j = 0; j < 3; ++j) { p0 = __builtin_amdgcn_mfma_f32_32x32x16_bf16(b0[j], qr[g * 3 + j], p0, 0, 0, 0); p1 = __builtin_amdgcn_mfma_f32_32x32x16_bf16(b1[j], qr[g * 3 + j], p1, 0, 0, 0); }
        SBAR();
    }
}
__device__ __forceinline__ void pv_tile(f32x16* o, int vb, bf16x8 pa0, bf16x8 pa1, bf16x8 pa2, bf16x8 pa3) {
#define TRRD(dst, off) asm volatile("ds_read_b64_tr_b16 %0, %1 offset:%2" : "=&v"(dst) : "v"(vb), "i"(off) : "memory")
#define PV_D0(d0) do { s16x4 l0, l1, l2, l3, h0, h1, h2, h3; constexpr int b_ = (d0) * 512; \
        TRRD(l0, b_); TRRD(h0, b_ + 2048); TRRD(l1, b_ + 4096); TRRD(h1, b_ + 6144); TRRD(l2, b_ + 8192); TRRD(h2, b_ + 10240); TRRD(l3, b_ + 12288); TRRD(h3, b_ + 14336); \
        asm volatile("s_waitcnt lgkmcnt(0)" ::: "memory"); SBAR(); \
        o[d0] = __builtin_amdgcn_mfma_f32_32x32x16_bf16(pa0, (bf16x8){l0[0], l0[1], l0[2], l0[3], h0[0], h0[1], h0[2], h0[3]}, o[d0], 0, 0, 0); \
        o[d0] = __builtin_amdgcn_mfma_f32_32x32x16_bf16(pa1, (bf16x8){l1[0], l1[1], l1[2], l1[3], h1[0], h1[1], h1[2], h1[3]}, o[d0], 0, 0, 0); \
        o[d0] = __builtin_amdgcn_mfma_f32_32x32x16_bf16(pa2, (bf16x8){l2[0], l2[1], l2[2], l2[3], h2[0], h2[1], h2[2], h2[3]}, o[d0], 0, 0, 0); \
        o[d0] = __builtin_amdgcn_mfma_f32_32x32x16_bf16(pa3, (bf16x8){l3[0], l3[1], l3[2], l3[3], h3[0], h3[1], h3[2], h3[3]}, o[d0], 0, 0, 0); } while (0)
    PV_D0(0); PV_D0(1); PV_D0(2); PV_D0(3);
#undef PV_D0
#undef TRRD
}
__device__ __forceinline__ void attn_unit(int b, int h, int qb, const bf16_t* Q, const bf16_t* KN, const bf16_t* KR, const bf16_t* V, bf16_t* Y, char* lds, const int tid) {
    const int wid = __builtin_amdgcn_readfirstlane(tid >> 6), lane = tid & 63, r32 = lane & 31, hi = lane >> 5;
    const size_t rowbase = (size_t)b * SEQ; const int q0 = qb * 256, qlo = q0 + wid * 32;
    bf16x8 qr[12];
    { const bf16_t* qp = Q + (rowbase + qlo + r32) * 1536 + h * QKD + hi * 8;
#pragma unroll
      for (int d0 = 0; d0 < 12; ++d0) qr[d0] = *reinterpret_cast<const bf16x8*>(qp + d0 * 16); }
    const int NT = 4 * (qb + 1);
    char* V_lds = lds + OFF_V; char* K_lds = lds + OFF_K;
    float* ws = (float*)(lds + OFF_WS) + wid * 64; float* li_l = ws; float* al_l = ws + 32;
    const char* kbase = (const char*)(KN + rowbase * 1024 + h * 128); const char* rbase = (const char*)(KR + rowbase * 64); const char* vbase = (const char*)(V + rowbase * 1024 + h * 128);
    const char* ksrc[4]; unsigned kstr[4]; const char* vsrc[2];
#pragma unroll
    for (int i = 0; i < 4; ++i) { const int o_ = 1024 * (wid + 8 * i) + 16 * lane, row = o_ / KSTR, cb = o_ - row * KSTR;
        if (cb < 256) { ksrc[i] = kbase + row * 2048 + cb; kstr[i] = 131072u; } else if (cb < 384) { ksrc[i] = rbase + row * 128 + (cb - 256); kstr[i] = 8192u; } else { ksrc[i] = kbase + row * 2048; kstr[i] = 131072u; } }
#pragma unroll
    for (int i = 0; i < 2; ++i) { const int o_ = 1024 * (wid + 8 * i) + 16 * lane, st_ = o_ >> 9, kk = (st_ >> 2) * 8 + ((o_ >> 6) & 7), k = (kk & ~0xC) | ((kk & 4) << 1) | ((kk & 8) >> 1), c = (st_ & 3) * 32 + ((o_ & 63) >> 1);
        vsrc[i] = vbase + k * 2048 + c * 2; }
    LAS unsigned char* lds3 = (LAS unsigned char*)lds;
#define DMA_TILE(bf) do { _Pragma("unroll") for (int i_ = 0; i_ < 4; ++i_) if (i_ < 3 || wid == 0) { \
            __builtin_amdgcn_global_load_lds((const unsigned*)ksrc[i_], (LAS unsigned*)(lds3 + OFF_K + (bf) * SHM_K + (wid + 8 * i_) * 1024), 16, 0, 0); ksrc[i_] += kstr[i_]; } \
        _Pragma("unroll") for (int i_ = 0; i_ < 2; ++i_) { __builtin_amdgcn_global_load_lds((const unsigned*)vsrc[i_], (LAS unsigned*)(lds3 + OFF_V + (bf) * SHM_V + (wid + 8 * i_) * 1024), 16, 0, 0); vsrc[i_] += 131072; } } while (0)
    float m_reg = -1e30f, l_reg = 0.f; f32x16 o[4] = {};
    const int vb0 = (int)(uintptr_t)V_lds + v_rd_base(lane);
    const int qrow = qlo + r32;
    DMA_TILE(0); VM_WAIT(); __syncthreads();
    for (int t = 0; t < NT; ++t) {
        const int buf = t & 1, kb = t * 64;
        if (t + 1 < NT) DMA_TILE(buf ^ 1);
        SBAR();
        if (kb <= qlo + 31) {
            f32x16 p0, p1; float mn, al; bf16x8 pa0, pa1, pa2, pa3;
            qkt(p0, p1, K_lds + buf * SHM_K + r32 * KSTR + hi * 16, qr);
            if (kb + 63 > qlo) mask_tile(p0, p1, qrow - kb - 4 * hi);
            partialSM(p0, p1, m_reg, mn, al);
            finishSM(p0, p1, mn, al, l_reg, pa0, pa1, pa2, pa3);
            if (__any(al < 1.f)) { if (hi == 0) al_l[r32] = al; LDS_WAIT();
#pragma unroll
                for (int d_ = 0; d_ < 4; ++d_)
#pragma unroll
                    for (int r = 0; r < 16; ++r) o[d_][r] *= al_l[crow(r, hi)]; }
            SBAR();
            pv_tile(o, vb0 + buf * SHM_V, pa0, pa1, pa2, pa3);
        }
        SBAR();
        VM_WAIT();
        __syncthreads();
    }
    if (hi == 0) li_l[r32] = l_reg; LDS_WAIT();
    bf16_t* Ow = Y + (rowbase + qlo) * DM + 1024 + h * 128;
#pragma unroll
    for (int r = 0; r < 16; ++r) { const int orow = crow(r, hi); const float rl = __builtin_amdgcn_rcpf(li_l[orow]);
#pragma unroll
        for (int d0 = 0; d0 < 4; ++d0) { const float v = o[d0][r] * rl; const float vn = __shfl_xor(v, 1);
            if ((r32 & 1) == 0) *(unsigned*)(Ow + (size_t)orow * DM + d0 * 32 + r32) = cvt_pk_bf16(v, vn); } }
    __syncthreads();
#undef DMA_TILE
}
#undef SBAR
}

#define XB_TMO      128
#define XB_XCNT(j)  (256  + 64 * (j))
#define XB_XSUB(j)  (1280 + 64 * (j))
#define XB_XGEN(j)  (2304 + 64 * (j))
#define XB_TOP      3328
#define XB_TOPGEN   3392
#define XCD_BAR_WORDS 3456
#define XB_SPIN_CAP (1u << 18)
__device__ __forceinline__ unsigned xb_ld(unsigned* p)              { return __hip_atomic_load(p, __ATOMIC_RELAXED, __HIP_MEMORY_SCOPE_AGENT); }
__device__ __forceinline__ unsigned xb_add(unsigned* p, unsigned v) { return __hip_atomic_fetch_add(p, v, __ATOMIC_RELAXED, __HIP_MEMORY_SCOPE_AGENT); }
__device__ __forceinline__ unsigned xb_xcc_id() { return (unsigned)__builtin_amdgcn_s_getreg((3 << 11) | 20) & 0xFu; }
#define XB_SPIN(cond, bar) do { unsigned _sp = 0; while (cond) { __builtin_amdgcn_s_sleep(1); \
    if ((++_sp & 255u) == 0u) { if (xb_ld(&(bar)[XB_TMO])) break; if (_sp > XB_SPIN_CAP) { atomicAdd(&(bar)[XB_TMO], 1u); break; } } } } while (0)
struct XcdBarrier { unsigned* bar; unsigned x; volatile LAS unsigned* st; };
__device__ __forceinline__ XcdBarrier xcd_barrier_post(unsigned* bar, volatile LAS unsigned* st) {
    XcdBarrier b; b.bar = bar; b.x = xb_xcc_id(); b.st = st;
    if (threadIdx.x == 0) (void)xb_add(&bar[XB_XCNT(b.x)], 1u);
    return b;
}
__device__ __forceinline__ void xcd_barrier_complete(unsigned* bar, unsigned x, unsigned& nloc, unsigned& nx) {
    const unsigned G = gridDim.x * gridDim.y * gridDim.z;
    unsigned sum, cnt, mine, sp = 0u;
    for (;;) {
        sum = 0u; cnt = 0u; mine = 0u;
#pragma unroll
        for (unsigned j = 0; j < 16; ++j) { const unsigned c = xb_ld(&bar[XB_XCNT(j)]); sum += c; cnt += (c > 0u) ? 1u : 0u; mine = (j == x) ? c : mine; }
        if (sum == G) break;
        __builtin_amdgcn_s_sleep(1);
        if ((++sp & 255u) == 0u) { if (xb_ld(&bar[XB_TMO])) break; if (sp > XB_SPIN_CAP) { atomicAdd(&bar[XB_TMO], 1u); break; } }
    }
    nloc = mine > 0u ? mine : 1u; nx = cnt > 0u ? cnt : 1u;
}
__device__ __forceinline__ void xcd_barrier(const XcdBarrier& b) {
    asm volatile("s_waitcnt vmcnt(0)" ::: "memory");
    __syncthreads();
    if (threadIdx.x == 0) {
        unsigned* bar = b.bar;
        __builtin_amdgcn_s_waitcnt(0);
        unsigned nloc = b.st[0], nx = b.st[1];
        if (nloc == 0u) { xcd_barrier_complete(bar, b.x, nloc, nx); b.st[0] = nloc; b.st[1] = nx; }
        const unsigned old = xb_add(&bar[XB_XSUB(b.x)], 1u);
        const unsigned gen = old / nloc;
        if (old + 1u == (gen + 1u) * nloc) {
            __builtin_amdgcn_fence(__ATOMIC_RELEASE, "agent");
            asm volatile("s_waitcnt vmcnt(0)" ::: "memory");
            const unsigned og = xb_add(&bar[XB_TOP], 1u);
            const unsigned tg = og / nx;
            if (og + 1u == (tg + 1u) * nx) xb_add(&bar[XB_TOPGEN], 1u);
            else XB_SPIN(xb_ld(&bar[XB_TOPGEN]) == tg, bar);
            __builtin_amdgcn_fence(__ATOMIC_ACQUIRE, "agent");
            xb_add(&bar[XB_XGEN(b.x)], 1u);
            asm volatile("s_waitcnt vmcnt(0)" ::: "memory");
        } else {
            XB_SPIN(xb_ld(&bar[XB_XGEN(b.x)]) == gen, bar);
            __builtin_amdgcn_fence(__ATOMIC_ACQUIRE, "agent");
            asm volatile("s_waitcnt vmcnt(0)" ::: "memory");
        }
    }
    __syncthreads();
}

struct Args {
    const float* in[22]; float* out; unsigned char* ws; float inv_freq[32]; int ph_lo, ph_hi;
};
struct Frame {
    LAS unsigned char* lds; int wave, G, blk, vcu;
};
#if FOLD_QKV_NORM
enum { PH_PRO = 0, PH_PROJ, PH_QKV, PH_ATTN, PH_WOUT, PH_NORM1, PH_FFNUP, PH_FFNDN, PH_POOL, PH_POOLG, PH_ROUTE, PH_SORT, PH_MOEUP, PH_MOEDN, PH_FINAL, NPH };
#else
enum { PH_PRO = 0, PH_PROJ, PH_CONV, PH_QKV, PH_ATTN, PH_WOUT, PH_NORM1, PH_FFNUP, PH_FFNDN, PH_POOL, PH_POOLG, PH_ROUTE, PH_SORT, PH_MOEUP, PH_MOEDN, PH_FINAL, NPH };
#endif
enum { I_X = 0, I_NMIX0, I_WIN, I_CONVW, I_QNORM, I_WUQ, I_KVNORM, I_WUKV, I_WOUT, I_NFFN0, I_FG, I_FU, I_FD, I_NMIX1, I_POOLW, I_POOLS, I_NFFN1, I_ROUTER, I_MG, I_MU, I_MD, I_FNORM };

__device__ __forceinline__ void sincos_d(double a, double& sn, double& cs) {
    const double k = rint(a * 0.63661977236758134308); const double r = (a - k * 1.57079632679489655800) - k * 6.12323399573676603587e-17; const double r2 = r * r;
    double s = -1.0 / 1307674368000.0; s = s * r2 + 1.0 / 6227020800.0; s = s * r2 - 1.0 / 39916800.0; s = s * r2 + 1.0 / 362880.0; s = s * r2 - 1.0 / 5040.0; s = s * r2 + 1.0 / 120.0; s = s * r2 - 1.0 / 6.0; s = s * r2 * r + r;
    double c = 1.0 / 20922789888000.0; c = c * r2 - 1.0 / 87178291200.0; c = c * r2 + 1.0 / 479001600.0; c = c * r2 - 1.0 / 3628800.0; c = c * r2 + 1.0 / 40320.0; c = c * r2 - 1.0 / 720.0; c = c * r2 + 1.0 / 24.0; c = c * r2 - 0.5; c = c * r2 + 1.0;
    const int q = (int)((long long)k & 3);
    sn = (q == 0) ? s : (q == 1) ? c : (q == 2) ? -s : -c; cs = (q == 0) ? c : (q == 1) ? -s : (q == 2) ? -c : s;
}
__device__ __forceinline__ int ropeperm(int j) { return j < 32 ? 2 * j : 2 * (j - 32) + 1; }
__device__ __forceinline__ int destrow(int mode, int n) {
    if (mode == 1) return n < 3840 ? n : 3840 + ropeperm(n - 3840);
    if (mode == 2) { const int h = n / QKD, d = n - h * QKD; return d < 128 ? n : h * QKD + 128 + ropeperm(d - 128); }
    if (mode == 3) return (n >> 7) * 256 + (n & 127);
    return n;
}
__device__ __forceinline__ void p0_transpose_item(const float* W, int K, int N, bf16_t* WT, int mode, int row_off, LAS float* scr, int item, int lane, const float* kscale = nullptr) {
    const int nblk = N / 32, kb = item / nblk, nb = item % nblk, k0 = 64 * kb, n0 = 32 * nb;
    float t_[32];
#pragma unroll
    for (int i = 0; i < 32; ++i) { const int kk = 2 * i + (lane >> 5); t_[i] = __builtin_nontemporal_load(W + (size_t)(k0 + kk) * N + n0 + (lane & 31)); }
#pragma unroll
    for (int i = 0; i < 32; ++i) { const int kk = 2 * i + (lane >> 5); scr[kk * 33 + (lane & 31)] = kscale ? t_[i] * kscale[k0 + kk] : t_[i]; }
    LDS_WAIT(); asm volatile("" ::: "memory");
    const int c = lane & 7;
#pragma unroll
    for (int j = 0; j < 4; ++j) { const int n = (lane >> 3) + 8 * j; const LAS float* s = scr + (8 * c) * 33 + n;
        u32x4 o; o.x = cvt_pk_bf16(s[0 * 33], s[1 * 33]); o.y = cvt_pk_bf16(s[2 * 33], s[3 * 33]); o.z = cvt_pk_bf16(s[4 * 33], s[5 * 33]); o.w = cvt_pk_bf16(s[6 * 33], s[7 * 33]);
        *(u32x4*)(WT + (size_t)(destrow(mode, n0 + n) + row_off) * K + k0 + 8 * c) = o; }
    LDS_WAIT(); asm volatile("" ::: "memory");
}
__device__ __forceinline__ void p0_transpose_item8(const float* W, int K, int N, unsigned char* WT, int mode, int row_off, float scale, LAS float* scr, int item, int lane) {
    const int nblk = N / 32, kb = item / nblk, nb = item % nblk, k0 = 64 * kb, n0 = 32 * nb;
    float t_[32];
#pragma unroll
    for (int i = 0; i < 32; ++i) { const int kk = 2 * i + (lane >> 5); t_[i] = __builtin_nontemporal_load(W + (size_t)(k0 + kk) * N + n0 + (lane & 31)); }
#pragma unroll
    for (int i = 0; i < 32; ++i) { const int kk = 2 * i + (lane >> 5); scr[kk * 33 + (lane & 31)] = t_[i] * scale; }
    LDS_WAIT(); asm volatile("" ::: "memory");
    const int c = lane & 3;
#pragma unroll
    for (int j = 0; j < 2; ++j) { const int n = (lane >> 2) + 16 * j; const LAS float* s = scr + (16 * c) * 33 + n; u32x4 o;
#pragma unroll
        for (int q = 0; q < 4; ++q) { int t = __builtin_amdgcn_cvt_pk_fp8_f32(s[(4 * q) * 33], s[(4 * q + 1) * 33], 0, false); t = __builtin_amdgcn_cvt_pk_fp8_f32(s[(4 * q + 2) * 33], s[(4 * q + 3) * 33], t, true); o[q] = (unsigned)t; }
        *(u32x4*)(WT + (size_t)(destrow(mode, n0 + n) + row_off) * K + k0 + 16 * c) = o; }
    LDS_WAIT(); asm volatile("" ::: "memory");
}
__device__ __forceinline__ void p0_transpose_item_i8(const float* W, int K, int N, unsigned char* WT, int mode, int row_off, float scale, LAS float* scr, int item, int lane) {
    const int nblk = N / 32, kb = item / nblk, nb = item % nblk, k0 = 64 * kb, n0 = 32 * nb;
    float t_[32];
#pragma unroll
    for (int i = 0; i < 32; ++i) { const int kk = 2 * i + (lane >> 5); t_[i] = __builtin_nontemporal_load(W + (size_t)(k0 + kk) * N + n0 + (lane & 31)); }
#pragma unroll
    for (int i = 0; i < 32; ++i) { const int kk = 2 * i + (lane >> 5); scr[kk * 33 + (lane & 31)] = t_[i] * scale; }
    LDS_WAIT(); asm volatile("" ::: "memory");
    const int c = lane & 3;
#pragma unroll
    for (int j = 0; j < 2; ++j) { const int n = (lane >> 2) + 16 * j; const LAS float* s = scr + (16 * c) * 33 + n; u32x4 o;
#pragma unroll
        for (int q = 0; q < 4; ++q) { unsigned w = 0u;
#pragma unroll
            for (int b = 0; b < 4; ++b) { int v = __float2int_rn(s[(4 * q + b) * 33]); v = v > 127 ? 127 : (v < -127 ? -127 : v); w |= ((unsigned)v & 0xffu) << (8 * b); }
            o[q] = w; }
        *(u32x4*)(WT + (size_t)(destrow(mode, n0 + n) + row_off) * K + k0 + 16 * c) = o; }
    LDS_WAIT(); asm volatile("" ::: "memory");
}
template <class XT> __device__ __forceinline__ void rms_row_bf16(const XT* xrow, const float* g, bf16_t* orow, int lane) {
    f32x4 v[8]; float s = 0.f;
#pragma unroll
    for (int j = 0; j < 8; ++j) { v[j] = ldrow4(xrow + 4 * (lane + 64 * j)); s += (v[j][0] * v[j][0] + v[j][1] * v[j][1]) + (v[j][2] * v[j][2] + v[j][3] * v[j][3]); }
    const float rstd = 1.0f / sqrtf(wave_sum(s) * (1.f / DM) + EPS);
    const f32x4* gr = (const f32x4*)g + lane; u32x2* o8 = (u32x2*)orow + lane;
#pragma unroll
    for (int j = 0; j < 8; ++j) { const f32x4 gv = gr[64 * j]; const f32x4 y = v[j] * rstd * gv; u32x2 w; w.x = cvt_pk_bf16(y[0], y[1]); w.y = cvt_pk_bf16(y[2], y[3]); o8[64 * j] = w; }
}

template <int W> __device__ __forceinline__ void pool_rows(const res_t* xc, bf16_t* oc, const LAS float* rs, const f32x4 gv, int s0) {
    f32x4 prev[16], cur[16]; f32x4 S = {0.f, 0.f, 0.f, 0.f};
#pragma unroll
    for (int j = 0; j < 16; ++j) prev[j] = (f32x4){0.f, 0.f, 0.f, 0.f};
    if (s0 > 0) {
#pragma unroll
        for (int j = 1; j < W; ++j) { prev[16 - j] = ldres4(xc - (size_t)j * DM) * rs[16 - j] * gv; S += prev[16 - j]; } }
#pragma unroll 1
    for (int c = 0; c < 4; ++c) {
#pragma unroll
        for (int i = 0; i < 16; ++i) cur[i] = ldres4(xc + (size_t)(c * 16 + i) * DM);
#pragma unroll
        for (int i = 0; i < 16; ++i) { const int s = s0 + c * 16 + i; cur[i] = cur[i] * rs[16 + c * 16 + i] * gv; S += cur[i];
            const float inv = (s + 1 < W) ? 1.0f / (float)(s + 1) : 1.0f / (float)W; const f32x4 p = S * inv - cur[i];
            u32x2 o; o.x = cvt_pk_bf16(p[0], p[1]); o.y = cvt_pk_bf16(p[2], p[3]); *(u32x2*)(oc + (size_t)(c * 16 + i) * DM) = o;
            S -= (i - (W - 1) >= 0) ? cur[i - (W - 1) >= 0 ? i - (W - 1) : 0] : prev[16 + i - (W - 1) < 16 ? 16 + i - (W - 1) : 15]; }
#pragma unroll
        for (int i = 0; i < 16; ++i) prev[i] = cur[i];
    }
}
constexpr int CI_IN = 32 * (INC / 32), CI_UQ = 8 * 48, CI_UKV = 4 * 64, CI_OUT = 32 * 64, CI_FGU = 32 * 176, CI_FDN = 88 * 64, CI_PL = 8 * 16, CI_MGU = 32 * 88, CI_MDN = 44 * 64;
constexpr int CV_MOE = 16 * CI_MGU + 8 * CI_MDN, CV_FFN = 2 * CI_FGU + CI_FDN, CV_ALL = CV_MOE + CV_FFN + CI_IN + CI_OUT + CI_UQ + CI_UKV + 4 * CI_PL;
__device__ __forceinline__ void conv_item(const __attribute__((address_space(4))) Args* A_, unsigned char* ws, int r, LAS float* scr, int lane, float i8scale = 1.f) {
    if (r < 16 * CI_MGU) { const int w = r / (8 * CI_MGU), rr = r % (8 * CI_MGU), e = rr / CI_MGU, ii = rr % CI_MGU;
        p0_transpose_item8(A_->in[w ? I_MU : I_MG] + (size_t)e * DM * FE, DM, FE, ws + WS_W_MGU + (size_t)e * 2 * FE * DM, 3, w ? 128 : 0, 64.f, scr, ii, lane); return; } r -= 16 * CI_MGU;
    if (r < 8 * CI_MDN) { const int e = r / CI_MDN, ii = r % CI_MDN; p0_transpose_item8(A_->in[I_MD] + (size_t)e * FE * DM, FE, DM, ws + WS_W_MDN + (size_t)e * DM * FE, 0, 0, 64.f, scr, ii, lane); return; } r -= 8 * CI_MDN;
    if (r < 2 * CI_FGU) { const int w = r / CI_FGU, ii = r % CI_FGU;
        if (FFN_UP_I8) p0_transpose_item_i8(A_->in[w ? I_FU : I_FG], DM, FF, ws + WS_W_GU, 3, w ? 128 : 0, i8scale, scr, ii, lane); else if (FFN_UP_FP8) p0_transpose_item8(A_->in[w ? I_FU : I_FG], DM, FF, ws + WS_W_GU, 3, w ? 128 : 0, 64.f, scr, ii, lane); else p0_transpose_item(A_->in[w ? I_FU : I_FG], DM, FF, (bf16_t*)(ws + WS_W_GU), 3, w ? 128 : 0, scr, ii, lane); return; } r -= 2 * CI_FGU;
    if (r < CI_FDN) { if (FFN_DN_FP8) p0_transpose_item8(A_->in[I_FD], FF, DM, ws + WS_W_DN, 0, 0, 64.f, scr, r, lane); else p0_transpose_item(A_->in[I_FD], FF, DM, (bf16_t*)(ws + WS_W_DN), 0, 0, scr, r, lane); return; } r -= CI_FDN;
    if (r < CI_IN) { p0_transpose_item(A_->in[I_WIN], DM, INC, (bf16_t*)(ws + WS_W_IN), 1, 0, scr, r, lane); return; } r -= CI_IN;
    if (r < CI_OUT) { p0_transpose_item(A_->in[I_WOUT], DM, DM, (bf16_t*)(ws + WS_W_OUT), 0, 0, scr, r, lane); return; } r -= CI_OUT;
    if (r < CI_UQ) { p0_transpose_item(A_->in[I_WUQ], QLORA, NH * QKD, (bf16_t*)(ws + WS_W_UQ), 2, 0, scr, r, lane, FOLD_QKV_NORM ? A_->in[I_QNORM] : nullptr); return; } r -= CI_UQ;
    if (r < CI_UKV) { p0_transpose_item(A_->in[I_WUKV], KVLORA, NH * 256, (bf16_t*)(ws + WS_W_UKV), 0, 0, scr, r, lane, FOLD_QKV_NORM ? A_->in[I_KVNORM] : nullptr); return; } r -= CI_UKV;
    { const int gidx = r / CI_PL, ii = r % CI_PL; p0_transpose_item(A_->in[I_POOLW] + (size_t)gidx * 512 * 512, 512, 512, (bf16_t*)(ws + WS_W_POOL), 0, gidx * 512, scr, ii, lane); }
}
__device__ __forceinline__ void conv_colblock_i8(const __attribute__((address_space(4))) Args* A_, unsigned char* ws, int blkid, LAS unsigned char* lds, int wave, int lane) {
    const int w = blkid / (FF / 32), nb = blkid % (FF / 32), n0 = nb * 32, row_off = w ? 128 : 0;
    const float* W = A_->in[w ? I_FU : I_FG]; unsigned char* WT = ws + WS_W_GU; float* wsc = (float*)(ws + WS_MISC + MS_WSC);
    LAS float* scr = (LAS float*)(lds + wave * 16384); LAS float* cm = (LAS float*)(lds + 9216);
    float t[4][32]; float mx = 0.f;
    { const float* p = W + (size_t)(wave * 256 + (lane >> 5)) * FF + n0 + (lane & 31);
#pragma unroll
      for (int j = 0; j < 4; ++j)
#pragma unroll
        for (int i = 0; i < 32; ++i) { t[j][i] = __builtin_nontemporal_load(p); p += 2 * FF; if ((i & 7) == 7) asm volatile("" : "+v"(p)); } }
#pragma unroll
    for (int j = 0; j < 4; ++j)
#pragma unroll
        for (int i = 0; i < 32; ++i) mx = fmaxf(mx, fabsf(t[j][i]));
    mx = fmaxf(mx, __shfl_xor(mx, 32));
    if (lane < 32) cm[wave * 32 + lane] = mx;
    __syncthreads();
    float cmax = 0.f;
#pragma unroll
    for (int v = 0; v < 8; ++v) cmax = fmaxf(cmax, cm[v * 32 + (lane & 31)]);
    cmax = fmaxf(cmax, 1e-30f); const float sc = 127.f / cmax;
    if (wave == 0 && lane < 32) wsc[destrow(3, n0 + lane) + row_off] = cmax * (1.f / 127.f);
#pragma unroll
    for (int j = 0; j < 4; ++j) { const int k0 = wave * 256 + j * 64;
#pragma unroll
        for (int i = 0; i < 32; ++i) scr[(2 * i + (lane >> 5)) * 33 + (lane & 31)] = t[j][i] * sc;
        LDS_WAIT(); asm volatile("" ::: "memory");
        const int c = lane & 3;
#pragma unroll
        for (int jj = 0; jj < 2; ++jj) { const int n = (lane >> 2) + 16 * jj; const LAS float* sp = scr + (16 * c) * 33 + n; u32x4 o;
#pragma unroll
            for (int q = 0; q < 4; ++q) { unsigned wd = 0u;
#pragma unroll
                for (int b = 0; b < 4; ++b) { int v = __float2int_rn(sp[(4 * q + b) * 33]); v = v > 127 ? 127 : (v < -127 ? -127 : v); wd |= ((unsigned)v & 0xffu) << (8 * b); }
                o[q] = wd; }
            *(u32x4*)(WT + (size_t)(destrow(3, n0 + n) + row_off) * DM + k0 + 16 * c) = o; }
        LDS_WAIT(); asm volatile("" ::: "memory"); }
    __syncthreads();
}
__device__ __forceinline__ void conv_group(const __attribute__((address_space(4))) Args* A_, unsigned char* ws, int lo, int n, int blk, int G, int wave, LAS unsigned char* lds, int lane, float i8scale = 1.f) {
    const int grp = (blk >> 3) & 1, cu = (blk >> 4) * 8 + (blk & 7), NW = (G / 2) * NWAVES, half = n / 2;
    LAS float* scr = (LAS float*)(lds + wave * 16384);
    for (int it = cu * NWAVES + wave; it < half; it += NW) conv_item(A_, ws, lo + grp * half + it, scr, lane, i8scale);
    if (grp == 1 && (n & 1)) { if (cu == 0 && wave == 0) conv_item(A_, ws, lo + n - 1, scr, lane, i8scale); }
}
template <class XT> __device__ __forceinline__ void rms_row_i8(const XT* xrow, const float* g, unsigned char* orow, float* asc, int lane) {
    f32x4 v[8]; float s = 0.f;
#pragma unroll
    for (int j = 0; j < 8; ++j) { v[j] = ldrow4(xrow + 4 * (lane + 64 * j)); s += (v[j][0] * v[j][0] + v[j][1] * v[j][1]) + (v[j][2] * v[j][2] + v[j][3] * v[j][3]); }
    const float rstd = 1.0f / sqrtf(wave_sum(s) * (1.f / DM) + EPS);
    const f32x4* gr = (const f32x4*)g + lane; float mx = 0.f;
#pragma unroll
    for (int j = 0; j < 8; ++j) { v[j] = v[j] * rstd * gr[64 * j]; mx = fmaxf(fmaxf(mx, fmaxf(fabsf(v[j][0]), fabsf(v[j][1]))), fmaxf(fabsf(v[j][2]), fabsf(v[j][3]))); }
#pragma unroll
    for (int o = 1; o < 64; o <<= 1) mx = fmaxf(mx, __shfl_xor(mx, o));
    mx = fmaxf(mx, 1e-20f); const float sc = 127.f / mx; unsigned* o4 = (unsigned*)orow + lane;
#pragma unroll
    for (int j = 0; j < 8; ++j) { unsigned w = 0u;
#pragma unroll
        for (int b = 0; b < 4; ++b) { int q = __float2int_rn(v[j][b] * sc); q = q > 127 ? 127 : (q < -127 ? -127 : q); w |= ((unsigned)q & 0xffu) << (8 * b); }
        o4[64 * j] = w; }
    if (lane == 0) *asc = mx * (1.f / 127.f);
}
template <class XT> __device__ __forceinline__ void rms_row_fp8(const XT* xrow, const float* g, unsigned char* orow, int lane) {
    f32x4 v[8]; float s = 0.f;
#pragma unroll
    for (int j = 0; j < 8; ++j) { v[j] = ldrow4(xrow + 4 * (lane + 64 * j)); s += (v[j][0] * v[j][0] + v[j][1] * v[j][1]) + (v[j][2] * v[j][2] + v[j][3] * v[j][3]); }
    const float rstd = 1.0f / sqrtf(wave_sum(s) * (1.f / DM) + EPS);
    const f32x4* gr = (const f32x4*)g + lane; unsigned* o4 = (unsigned*)orow + lane;
#pragma unroll
    for (int j = 0; j < 8; ++j) { const f32x4 y = v[j] * rstd * gr[64 * j]; int t = __builtin_amdgcn_cvt_pk_fp8_f32(y[0], y[1], 0, false); t = __builtin_amdgcn_cvt_pk_fp8_f32(y[2], y[3], t, true); o4[64 * j] = (unsigned)t; }
}

__device__ __forceinline__ void conv_rowblock(int rb, const bf16_t* PROJ, bf16_t* YAB, const float* cw, int tid) {
    const int ch = (tid & 127) * 8, seg = tid >> 7, t0 = rb * 64 + seg * 16, s0 = t0 & (SEQ - 1);
    float w0[8], w1[8], w2[8], u1[8], u2[8];
#pragma unroll
    for (int j = 0; j < 8; ++j) { w0[j] = cw[ch + j]; w1[j] = cw[CONV + ch + j]; w2[j] = cw[2 * CONV + ch + j]; u1[j] = 0.f; u2[j] = 0.f; }
#pragma unroll
    for (int back = 2; back >= 1; --back) if (s0 >= back) { const bf16_t* pr = PROJ + (size_t)(t0 - back) * 3072 + ch; const u32x4 xi = *(const u32x4*)pr, gc = *(const u32x4*)(pr + 2048);
        float uu[8];
#pragma unroll
        for (int j = 0; j < 4; ++j) { uu[2 * j] = bflo(xi[j]) * bflo(gc[j]); uu[2 * j + 1] = bfhi(xi[j]) * bfhi(gc[j]); }
#pragma unroll
        for (int j = 0; j < 8; ++j) { if (back == 2) u2[j] = uu[j]; else u1[j] = uu[j]; } }
    for (int i = 0; i < 16; ++i) { const bf16_t* pr = PROJ + (size_t)(t0 + i) * 3072 + ch; const u32x4 xi = *(const u32x4*)pr, gb = *(const u32x4*)(pr + 1024), gc = *(const u32x4*)(pr + 2048);
        float uu[8], gbf[8], y[8];
#pragma unroll
        for (int j = 0; j < 4; ++j) { uu[2 * j] = bflo(xi[j]) * bflo(gc[j]); uu[2 * j + 1] = bfhi(xi[j]) * bfhi(gc[j]); gbf[2 * j] = bflo(gb[j]); gbf[2 * j + 1] = bfhi(gb[j]); }
#pragma unroll
        for (int j = 0; j < 8; ++j) { y[j] = gbf[j] * (w0[j] * u2[j] + w1[j] * u1[j] + w2[j] * uu[j]); u2[j] = u1[j]; u1[j] = uu[j]; }
        u32x4 o; o.x = cvt_pk_bf16(y[0], y[1]); o.y = cvt_pk_bf16(y[2], y[3]); o.z = cvt_pk_bf16(y[4], y[5]); o.w = cvt_pk_bf16(y[6], y[7]);
        *(u32x4*)(YAB + (size_t)(t0 + i) * DM + ch) = o; }
}

__global__ void __launch_bounds__(NTHREADS, 2) fwd_kernel(Args args) {
    extern __shared__ __attribute__((aligned(16))) unsigned char lds_raw[];
    Frame F;
    F.lds = (LAS unsigned char*)lds_raw;
    F.wave = __builtin_amdgcn_readfirstlane((int)threadIdx.x >> 6);
    F.G = gridDim.x; F.blk = blockIdx.x; F.vcu = (F.G % 8 == 0) ? (F.blk % 8) * (F.G / 8) + F.blk / 8 : F.blk;
    unsigned* ctl = (unsigned*)(args.ws + WS_CTL);
    const int lo = args.ph_lo, hi = args.ph_hi;
    if (threadIdx.x < 4) ((LAS unsigned*)(F.lds + LX_BAR))[threadIdx.x] = 0u;
    __syncthreads();
    XcdBarrier bar; bar.bar = ctl + CW_BAR; bar.x = 0; bar.st = nullptr;
    if (hi - lo > 1) bar = xcd_barrier_post(ctl + CW_BAR, (volatile LAS unsigned*)(F.lds + LX_BAR));
#define IN(k) (lo <= (k) && (k) < hi)
#define PHASE_PTRS() \
    const __attribute__((address_space(4))) Args* A_ = (const __attribute__((address_space(4))) Args*)__builtin_amdgcn_kernarg_segment_ptr(); asm volatile("" : "+s"(A_)); \
    int tid_ = threadIdx.x; asm volatile("" : "+v"(tid_)); const int tid = tid_, lane = tid_ & 63; (void)tid; (void)lane; \
    unsigned char* ws = A_->ws; const float* x = A_->in[I_X]; res_t* XR = RES_BF16 ? (res_t*)(ws + WS_XRB) : (res_t*)A_->out; (void)x; (void)XR; \
    float* ROPE = (float*)(ws + WS_ROPE); (void)ROPE; \
    bf16_t* W_IN = (bf16_t*)(ws + WS_W_IN); bf16_t* W_UQ = (bf16_t*)(ws + WS_W_UQ); bf16_t* W_UKV = (bf16_t*)(ws + WS_W_UKV); bf16_t* W_OUT = (bf16_t*)(ws + WS_W_OUT); \
    bf16_t* W_GU = (bf16_t*)(ws + WS_W_GU); bf16_t* W_DN = (bf16_t*)(ws + WS_W_DN); bf16_t* W_POOL = (bf16_t*)(ws + WS_W_POOL); bf16_t* W_MGU = (bf16_t*)(ws + WS_W_MGU); bf16_t* W_MDN = (bf16_t*)(ws + WS_W_MDN); \
    bf16_t* XBA = (bf16_t*)(ws + WS_XBA); bf16_t* XBB = (bf16_t*)(ws + WS_XBB); \
    bf16_t* PROJ = (bf16_t*)(ws + WS_PROJ); bf16_t* QB = (bf16_t*)(ws + WS_Q); bf16_t* KNB = (bf16_t*)(ws + WS_KN); bf16_t* CQ = (bf16_t*)(ws + WS_CQ); bf16_t* CKV = (bf16_t*)(ws + WS_CKV); \
    bf16_t* KRB = (bf16_t*)(ws + WS_KR); bf16_t* VB = (bf16_t*)(ws + WS_V); bf16_t* YAB = (bf16_t*)(ws + WS_YAB); bf16_t* HB = (bf16_t*)(ws + WS_H); bf16_t* HMOE = (bf16_t*)(ws + WS_HMOE); bf16_t* YMOE = (bf16_t*)(ws + WS_YMOE); \
    int* TOPI = (int*)(ws + WS_MISC + MS_TOPI); float* TOPP = (float*)(ws + WS_MISC + MS_TOPP); int* CNT = (int*)(ws + WS_MISC + MS_CNT); \
    int* PERM = (int*)(ws + WS_MISC + MS_PERM); float* GATE = (float*)(ws + WS_MISC + MS_GATE); int* DEST = (int*)(ws + WS_MISC + MS_DEST); int* TILE = (int*)(ws + WS_MISC + MS_TILE); \
    (void)W_IN; (void)W_UQ; (void)W_UKV; (void)W_OUT; (void)W_GU; (void)W_DN; (void)W_POOL; (void)W_MGU; (void)W_MDN; (void)XBA; (void)XBB; (void)PROJ; (void)QB; (void)KNB; (void)CQ; (void)CKV; (void)KRB; (void)VB; (void)YAB; (void)HB; (void)HMOE; (void)YMOE; \
    (void)TOPI; (void)TOPP; (void)CNT; (void)PERM; (void)GATE; (void)DEST; (void)TILE
#define AIN(i) (A_->in[i])
#define SEAM(k) do { if (IN(k) && IN((k) + 1)) xcd_barrier(bar); } while (0)

    const int gw = F.vcu * NWAVES + F.wave, NGW = F.G * NWAVES;

    if (IN(PH_PRO)) { PHASE_PTRS();
        LAS float* scr = (LAS float*)(F.lds + F.wave * 16384);
        for (int it = (OVERLAP_CONV ? CV_MOE + CV_FFN : 0) + gw; it < CV_ALL; it += NGW) conv_item(A_, ws, it, scr, lane);
        if (FFN_UP_I8 && !I8_PERCOL) {
            const int gt = F.vcu * NTHREADS + tid, NGT = F.G * NTHREADS; float mx = 0.f;
#pragma unroll 1
            for (int w = 0; w < 2; ++w) { const f32x4* p = (const f32x4*)AIN(w ? I_FU : I_FG);
#pragma unroll 4
                for (int i = gt; i < DM * FF / 4; i += NGT) { const f32x4 v = __builtin_nontemporal_load(p + i); mx = fmaxf(fmaxf(mx, fmaxf(fabsf(v[0]), fabsf(v[1]))), fmaxf(fabsf(v[2]), fabsf(v[3]))); } }
#pragma unroll
            for (int o = 1; o < 64; o <<= 1) mx = fmaxf(mx, __shfl_xor(mx, o));
            if (lane == 0) atomicMax((unsigned*)(ws + WS_CTL) + CW_WMAX, __float_as_uint(mx)); }
        { const int gt = F.vcu * NTHREADS + tid, NGT = F.G * NTHREADS; u32x4* z = (u32x4*)(W_IN + (size_t)INC * DM);
          for (int i = gt; i < (INP - INC) * DM / 8; i += NGT) z[i] = (u32x4){0u, 0u, 0u, 0u};
          for (int i = gt; i < SEQ * 32; i += NGT) { const int pos = i >> 5, k = i & 31; const float ang = (float)pos * A_->inv_freq[k];
              double sn, cs; sincos_d((double)ang, sn, cs); ROPE[pos * 64 + k] = (float)cs; ROPE[pos * 64 + 32 + k] = (float)sn; } }
        for (int m = gw; m < M; m += NGW) rms_row_bf16(x + (size_t)m * DM, AIN(I_NMIX0), XBA + (size_t)m * DM, lane);
    }
    SEAM(PH_PRO);

    if (IN(PH_PROJ)) { PHASE_PTRS();
        pg8::GemmDesc g{XBA, W_IN, DM, DM, DM, 0, 0}; pg8::StaticOrder S; S.init(M / 256, INP / 256, F.G, F.blk, DM, DM);
        pg8::EpiProj E{PROJ, CQ, CKV, KRB, ROPE, FOLD_QKV_NORM ? (float*)(ws + WS_MISC + MS_SSQ2) : nullptr};
        const int cgrp = (F.blk >> 3) & 1;
        const float i8s = (FFN_UP_I8 && !I8_PERCOL) ? 127.f / __uint_as_float(__hip_atomic_load((unsigned*)(ws + WS_CTL) + CW_WMAX, __ATOMIC_RELAXED, __HIP_MEMORY_SCOPE_AGENT)) : 1.f;
        constexpr bool PC = FFN_UP_I8 && I8_PERCOL;
        constexpr int FLO = PC ? CV_MOE + 2 * CI_FGU : CV_MOE, FN = PC ? CI_FDN : CV_FFN, NCB = 2 * (FF / 32);
        if (OVERLAP_CONV && F.G % 16 == 0 && cgrp == 0) { const int cu = (F.blk >> 4) * 8 + (F.blk & 7);
            if (PC) { __syncthreads(); for (int b = cu; b < NCB / 2; b += F.G / 2) conv_colblock_i8(A_, ws, b, F.lds, F.wave, lane); }
            conv_group(A_, ws, FLO, FN, F.blk, F.G, F.wave, F.lds, lane, i8s); __syncthreads(); }
        pg8::gemm_phase<pg8::EpiProj, pg8::StaticOrder, true, false>(F.lds, g, S, E, tid);
        if (OVERLAP_CONV && F.G % 16 == 0 && cgrp == 1) { const int cu = (F.blk >> 4) * 8 + (F.blk & 7);
            if (PC) { for (int b = cu; b < NCB / 2; b += F.G / 2) conv_colblock_i8(A_, ws, NCB / 2 + b, F.lds, F.wave, lane); }
            conv_group(A_, ws, FLO, FN, F.blk, F.G, F.wave, F.lds, lane, i8s); }
        if (OVERLAP_CONV && F.G % 16 != 0) { if (PC) { for (int b = F.blk; b < NCB; b += F.G) conv_colblock_i8(A_, ws, b, F.lds, F.wave, lane); }
            LAS float* scr = (LAS float*)(F.lds + F.wave * 16384); for (int it = FLO + gw; it < FLO + FN; it += NGW) conv_item(A_, ws, it, scr, lane, i8s); }
    }
    SEAM(PH_PROJ);

#if !FOLD_QKV_NORM
    if (IN(PH_CONV)) { PHASE_PTRS();
        const float* cw = AIN(I_CONVW);
        for (int rb = F.blk; rb < M / 64; rb += F.G) {
            const int ch = (tid & 127) * 8, seg = tid >> 7, t0 = rb * 64 + seg * 16, s0 = t0 & (SEQ - 1);
            float w0[8], w1[8], w2[8], u1[8], u2[8];
#pragma unroll
            for (int j = 0; j < 8; ++j) { w0[j] = cw[ch + j]; w1[j] = cw[CONV + ch + j]; w2[j] = cw[2 * CONV + ch + j]; u1[j] = 0.f; u2[j] = 0.f; }
#pragma unroll
            for (int back = 2; back >= 1; --back) if (s0 >= back) { const bf16_t* pr = PROJ + (size_t)(t0 - back) * 3072 + ch; const u32x4 xi = *(const u32x4*)pr, gc = *(const u32x4*)(pr + 2048);
                float uu[8];
#pragma unroll
                for (int j = 0; j < 4; ++j) { uu[2 * j] = bflo(xi[j]) * bflo(gc[j]); uu[2 * j + 1] = bfhi(xi[j]) * bfhi(gc[j]); }
#pragma unroll
                for (int j = 0; j < 8; ++j) { if (back == 2) u2[j] = uu[j]; else u1[j] = uu[j]; } }
            for (int i = 0; i < 16; ++i) { const bf16_t* pr = PROJ + (size_t)(t0 + i) * 3072 + ch; const u32x4 xi = *(const u32x4*)pr, gb = *(const u32x4*)(pr + 1024), gc = *(const u32x4*)(pr + 2048);
                float uu[8], gbf[8], y[8];
#pragma unroll
                for (int j = 0; j < 4; ++j) { uu[2 * j] = bflo(xi[j]) * bflo(gc[j]); uu[2 * j + 1] = bfhi(xi[j]) * bfhi(gc[j]); gbf[2 * j] = bflo(gb[j]); gbf[2 * j + 1] = bfhi(gb[j]); }
#pragma unroll
                for (int j = 0; j < 8; ++j) { y[j] = gbf[j] * (w0[j] * u2[j] + w1[j] * u1[j] + w2[j] * uu[j]); u2[j] = u1[j]; u1[j] = uu[j]; }
                u32x4 o; o.x = cvt_pk_bf16(y[0], y[1]); o.y = cvt_pk_bf16(y[2], y[3]); o.z = cvt_pk_bf16(y[4], y[5]); o.w = cvt_pk_bf16(y[6], y[7]);
                *(u32x4*)(YAB + (size_t)(t0 + i) * DM + ch) = o; }
            for (int i = 0; i < 8; ++i) { const int row = rb * 64 + F.wave * 8 + i;
                { bf16_t* p = CQ + (size_t)row * QLORA + lane * 8; const u32x4 v = *(const u32x4*)p; float f[8], s = 0.f;
#pragma unroll
                  for (int j = 0; j < 4; ++j) { f[2 * j] = bflo(v[j]); f[2 * j + 1] = bfhi(v[j]); s += f[2 * j] * f[2 * j] + f[2 * j + 1] * f[2 * j + 1]; }
                  const float rstd = 1.0f / sqrtf(wave_sum(s) * (1.f / QLORA) + EPS); const float* gq = AIN(I_QNORM) + lane * 8;
                  u32x4 o; o.x = cvt_pk_bf16(f[0] * rstd * gq[0], f[1] * rstd * gq[1]); o.y = cvt_pk_bf16(f[2] * rstd * gq[2], f[3] * rstd * gq[3]);
                  o.z = cvt_pk_bf16(f[4] * rstd * gq[4], f[5] * rstd * gq[5]); o.w = cvt_pk_bf16(f[6] * rstd * gq[6], f[7] * rstd * gq[7]); *(u32x4*)p = o; }
                { bf16_t* p = CKV + (size_t)row * KVLORA + lane * 4; const u32x2 v = *(const u32x2*)p; float f[4], s = 0.f;
#pragma unroll
                  for (int j = 0; j < 2; ++j) { f[2 * j] = bflo(v[j]); f[2 * j + 1] = bfhi(v[j]); s += f[2 * j] * f[2 * j] + f[2 * j + 1] * f[2 * j + 1]; }
                  const float rstd = 1.0f / sqrtf(wave_sum(s) * (1.f / KVLORA) + EPS); const float* gk = AIN(I_KVNORM) + lane * 4;
                  u32x2 o; o.x = cvt_pk_bf16(f[0] * rstd * gk[0], f[1] * rstd * gk[1]); o.y = cvt_pk_bf16(f[2] * rstd * gk[2], f[3] * rstd * gk[3]); *(u32x2*)p = o; } }
        }
    }
    SEAM(PH_CONV);

#endif

    if (IN(PH_QKV)) { PHASE_PTRS();
#if FOLD_QKV_NORM
        const float* ssq2 = (const float*)(ws + WS_MISC + MS_SSQ2);
        { pg8::GemmDesc g{CKV, W_UKV, KVLORA, KVLORA, KVLORA, 0, 0}; pg8::StaticOrder S; S.init(M / 256, NH, F.G, F.blk, KVLORA, KVLORA);
          pg8::EpiKV E{KNB, VB, ssq2}; pg8::gemm_phase<pg8::EpiKV, pg8::StaticOrder, true, false>(F.lds, g, S, E, tid); }
        { pg8::GemmDesc g{CQ, W_UQ, QLORA, QLORA, QLORA, 0, 0}; pg8::StaticOrder S; S.init(M / 256, NH * QKD / 256, F.G, F.blk, QLORA, QLORA);
          int tidq = tid; asm volatile("" : "+v"(tidq));
          pg8::EpiQ E{QB, ROPE, ssq2}; pg8::gemm_phase<pg8::EpiQ, pg8::StaticOrder, true, false>(F.lds, g, S, E, tidq); }
        { constexpr int NQU = (M / 256) * (NH * QKD / 256), NRB = M / 64; const float* cw = AIN(I_CONVW);
          const int r = NQU % F.G, nidle = r ? F.G - r : F.G, me = r ? F.blk - r : F.blk;
          int tid2 = tid; asm volatile("" : "+v"(tid2));
          if (me >= 0) for (int rb = me; rb < NRB; rb += nidle) conv_rowblock(rb, PROJ, YAB, cw, tid2); }
#else
        { pg8::GemmDesc g{CQ, W_UQ, QLORA, QLORA, QLORA, 0, 0}; pg8::StaticOrder S; S.init(M / 256, NH * QKD / 256, F.G, F.blk, QLORA, QLORA);
          pg8::EpiQ E{QB, ROPE, nullptr}; pg8::gemm_phase<pg8::EpiQ, pg8::StaticOrder, true, false>(F.lds, g, S, E, tid); }
        { pg8::GemmDesc g{CKV, W_UKV, KVLORA, KVLORA, KVLORA, 0, 0}; pg8::StaticOrder S; S.init(M / 256, NH, F.G, F.blk, KVLORA, KVLORA);
          pg8::EpiKV E{KNB, VB, nullptr}; pg8::gemm_phase<pg8::EpiKV, pg8::StaticOrder, true, false>(F.lds, g, S, E, tid); }
#endif
    }
    SEAM(PH_QKV);

    if (IN(PH_ATTN)) { PHASE_PTRS();
        for (int L = F.vcu; L < 256; L += F.G) { const int bh = L >> 3, s = L & 7;
#pragma unroll 1
            for (int pass = 0; pass < 2; ++pass) att::attn_unit(bh >> 3, bh & 7, pass ? s : 15 - s, QB, KNB, KRB, VB, YAB, (char*)lds_raw, tid); }
    }
    SEAM(PH_ATTN);

    if (IN(PH_WOUT)) { PHASE_PTRS();
        pg8::GemmDesc g{YAB, W_OUT, DM, DM, DM, 0, 0}; pg8::StaticOrder S; S.init(M / 256, DM / 256, F.G, F.blk, DM, DM);
#if RES_BF16 && FFN_UP_I8 && FUSE_NORM1
        S.init(M / 256, DM / 256, F.G, F.blk, DM, DM, 0, 0, 4);
        pg8::EpiResNorm E{x, XR, AIN(I_NFFN0), (unsigned char*)XBA, (float*)(ws + WS_MISC + MS_ASC), (float*)(ws + WS_ST4), (unsigned*)(ws + WS_CTL) + CW_P4};
        pg8::gemm_phase<pg8::EpiResNorm, pg8::StaticOrder, true, false>(F.lds, g, S, E, tid);
#elif RES_BF16
        pg8::EpiResB<false, true> E{x, XR, nullptr, nullptr}; pg8::gemm_phase<pg8::EpiResB<false, true>, pg8::StaticOrder, true, false>(F.lds, g, S, E, tid);
#else
        pg8::EpiRes<false> E{x, XR, nullptr, nullptr}; pg8::gemm_phase<pg8::EpiRes<false>, pg8::StaticOrder, true, false>(F.lds, g, S, E, tid);
#endif
    }
    SEAM(PH_WOUT);

    if (IN(PH_NORM1) && !(RES_BF16 && FFN_UP_I8 && FUSE_NORM1)) { PHASE_PTRS();
        for (int m = gw; m < M; m += NGW) {
            if (FFN_UP_I8) rms_row_i8(XR + (size_t)m * DM, AIN(I_NFFN0), (unsigned char*)XBA + (size_t)m * DM, (float*)(ws + WS_MISC + MS_ASC) + m, lane);
            else if (FFN_UP_FP8) rms_row_fp8(XR + (size_t)m * DM, AIN(I_NFFN0), (unsigned char*)XBA + (size_t)m * DM, lane);
            else rms_row_bf16(XR + (size_t)m * DM, AIN(I_NFFN0), XBA + (size_t)m * DM, lane); } }
    if (!(RES_BF16 && FFN_UP_I8 && FUSE_NORM1)) SEAM(PH_NORM1);

    if (IN(PH_FFNUP)) { PHASE_PTRS();
        constexpr int UPM = FFN_UP_I8 ? 2 : (FFN_UP_FP8 ? 1 : 0); constexpr int KD = UPM ? DM / 2 : DM;
        pg8::GemmDesc g{XBA, W_GU, KD, KD, KD, 0x79797979, 0x7f7f7f7f}; pg8::StaticOrder S; S.init(M / 256, 2 * FF / 256, F.G, F.blk, KD, KD);
        const float wdq = (FFN_UP_I8 && !I8_PERCOL) ? __uint_as_float(__hip_atomic_load((unsigned*)(ws + WS_CTL) + CW_WMAX, __ATOMIC_RELAXED, __HIP_MEMORY_SCOPE_AGENT)) * (1.f / 127.f) : 1.f;
        pg8::EpiSwiGLU<FFN_DN_FP8 != 0, FFN_UP_I8 != 0> E{HB, FF, nullptr, FFN_UP_I8 ? (const float*)(ws + WS_MISC + MS_ASC) : nullptr, wdq, (FFN_UP_I8 && I8_PERCOL) ? (const float*)(ws + WS_MISC + MS_WSC) : nullptr};
        const int cgrp = (F.blk >> 3) & 1;
        if (OVERLAP_CONV && F.G % 16 == 0 && cgrp == 0) { conv_group(A_, ws, 0, 8 * CI_MGU, F.blk, F.G, F.wave, F.lds, lane); __syncthreads(); }
        pg8::gemm_phase<pg8::EpiSwiGLU<FFN_DN_FP8 != 0, FFN_UP_I8 != 0>, pg8::StaticOrder, true, false, UPM>(F.lds, g, S, E, tid);
        if (OVERLAP_CONV && F.G % 16 == 0 && cgrp == 1) conv_group(A_, ws, 0, 8 * CI_MGU, F.blk, F.G, F.wave, F.lds, lane);
        if (OVERLAP_CONV && F.G % 16 != 0) { LAS float* scr = (LAS float*)(F.lds + F.wave * 16384); for (int it = gw; it < 8 * CI_MGU; it += NGW) conv_item(A_, ws, it, scr, lane); }
    }
    SEAM(PH_FFNUP);

    if (IN(PH_FFNDN)) { PHASE_PTRS();
        constexpr int KF = FFN_DN_FP8 ? FF / 2 : FF;
        pg8::GemmDesc g{HB, W_DN, KF, KF, KF, 0x79797979, 0x7d7d7d7d}; pg8::StaticOrder S; S.init(M / 256, DM / 256, F.G, F.blk, KF, KF);
        #if RES_BF16
        typedef pg8::EpiResB<true, false> EpiDn;
#else
        typedef pg8::EpiRes<true> EpiDn;
#endif
        EpiDn E{XR, XR, nullptr, (float*)(ws + WS_SSQ)}; const int cgrp6 = (F.blk >> 3) & 1;
        if (OVERLAP_CONV && F.G % 16 == 0 && cgrp6 == 0) { conv_group(A_, ws, 8 * CI_MGU, 8 * CI_MGU, F.blk, F.G, F.wave, F.lds, lane); __syncthreads(); }
        pg8::gemm_phase<EpiDn, pg8::StaticOrder, true, false, FFN_DN_FP8 ? 1 : 0>(F.lds, g, S, E, tid);
        if (OVERLAP_CONV && F.G % 16 == 0 && cgrp6 == 1) conv_group(A_, ws, 8 * CI_MGU, 8 * CI_MGU, F.blk, F.G, F.wave, F.lds, lane);
        if (OVERLAP_CONV && F.G % 16 != 0) { LAS float* scr = (LAS float*)(F.lds + F.wave * 16384); for (int it = 8 * CI_MGU + gw; it < 16 * CI_MGU; it += NGW) conv_item(A_, ws, it, scr, lane); }
    }
    SEAM(PH_FFNDN);

    if (IN(PH_POOL)) { PHASE_PTRS();
        LAS float* rs = (LAS float*)F.lds;
        const float* gm = AIN(I_NMIX1); const float* ssq = (const float*)(ws + WS_SSQ);
        for (int rb = F.blk; rb < M / 64; rb += F.G) {
            const int r0 = rb * 64, s0 = r0 & (SEQ - 1);
            __syncthreads();
            if (tid < 80) { const int row = r0 - 16 + tid; float rstd = 0.f;
                if (s0 - 16 + tid >= 0) { const f32x4* p = (const f32x4*)(ssq + (size_t)row * 32); float q = 0.f;
#pragma unroll
                    for (int j = 0; j < 8; ++j) { const f32x4 v = p[j]; q += (v[0] + v[1]) + (v[2] + v[3]); }
                    rstd = 1.0f / sqrtf(q * (1.f / DM) + EPS); }
                rs[tid] = rstd; }
            __syncthreads();
            const int c4 = tid * 4; const f32x4 gv = *(const f32x4*)(gm + c4); const res_t* xc = XR + (size_t)r0 * DM + c4; bf16_t* oc = XBB + (size_t)r0 * DM + c4;
            switch (tid >> 7) { case 0: pool_rows<2>(xc, oc, rs, gv, s0); break; case 1: pool_rows<4>(xc, oc, rs, gv, s0); break; case 2: pool_rows<8>(xc, oc, rs, gv, s0); break; default: pool_rows<16>(xc, oc, rs, gv, s0); break; }
        }
        __syncthreads();
    }
    SEAM(PH_POOL);

    if (IN(PH_POOLG)) { PHASE_PTRS();
        pg8::GemmDesc g{XBB, W_POOL, DM, 512, 512, 0, 0}; pg8::StaticOrder S; S.init(M / 256, DM / 256, F.G, F.blk, DM, 512, 2, 512);
        #if RES_BF16
        pg8::EpiResB<false, false> E{XR, XR, AIN(I_POOLS), nullptr}; pg8::gemm_phase<pg8::EpiResB<false, false>, pg8::StaticOrder, true, false>(F.lds, g, S, E, tid);
#else
        pg8::EpiRes<false> E{XR, XR, AIN(I_POOLS), nullptr}; pg8::gemm_phase<pg8::EpiRes<false>, pg8::StaticOrder, true, false>(F.lds, g, S, E, tid);
#endif
    }
    SEAM(PH_POOLG);

    if (IN(PH_ROUTE)) { PHASE_PTRS();
        LAS float* RW = (LAS float*)F.lds;
        LAS int* lcnt = (LAS int*)(F.lds + 65536);
        const float* gn = AIN(I_NFFN1); const float* rw = AIN(I_ROUTER);
        __syncthreads();
        for (int idx = tid; idx < 16384; idx += NTHREADS) { const int e3 = idx & 3, ln = (idx >> 2) & 63, half = (idx >> 8) & 1, jq = idx >> 9; const int c = 4 * (ln + 64 * (jq >> 2)) + (jq & 3);
            RW[idx] = rw[c * NE + half * 4 + e3] * gn[c]; }
        for (int rb = F.blk; rb < M / 64; rb += F.G) {
            if (tid < NE) lcnt[tid] = 0;
            __syncthreads();
            for (int i = 0; i < 8; ++i) { const int m = rb * 64 + F.wave * 8 + i;
                const res_t* xr = XR + (size_t)m * DM; f32x4 v[8]; float s = 0.f; float lg[8] = {0.f, 0.f, 0.f, 0.f, 0.f, 0.f, 0.f, 0.f};
#pragma unroll
                for (int j = 0; j < 8; ++j) { v[j] = ldres4(xr + 4 * (lane + 64 * j)); s += (v[j][0] * v[j][0] + v[j][1] * v[j][1]) + (v[j][2] * v[j][2] + v[j][3] * v[j][3]); }
#pragma unroll
                for (int j = 0; j < 8; ++j)
#pragma unroll
                    for (int q = 0; q < 4; ++q) { const int jq = j * 4 + q; const f32x4 wa = *(const LAS f32x4*)(RW + ((jq * 2 + 0) * 64 + lane) * 4), wb = *(const LAS f32x4*)(RW + ((jq * 2 + 1) * 64 + lane) * 4);
                        const float xv = v[j][q]; lg[0] += xv * wa[0]; lg[1] += xv * wa[1]; lg[2] += xv * wa[2]; lg[3] += xv * wa[3]; lg[4] += xv * wb[0]; lg[5] += xv * wb[1]; lg[6] += xv * wb[2]; lg[7] += xv * wb[3]; }
                const float rstd = 1.0f / sqrtf(wave_sum(s) * (1.f / DM) + EPS);
#pragma unroll
                for (int e = 0; e < 8; ++e) lg[e] = wave_sum(lg[e]) * rstd;
                int i1 = 0; float l1 = lg[0];
#pragma unroll
                for (int e = 1; e < 8; ++e) if (lg[e] > l1) { l1 = lg[e]; i1 = e; }
                int i2 = -1; float l2 = -__builtin_inff();
#pragma unroll
                for (int e = 0; e < 8; ++e) if (e != i1 && lg[e] > l2) { l2 = lg[e]; i2 = e; }
                const float p1 = 1.0f / (1.0f + expf(l2 - l1)), p2 = 1.0f - p1;
                if (lane == 0) { TOPI[2 * m] = i1; TOPI[2 * m + 1] = i2; TOPP[2 * m] = p1; TOPP[2 * m + 1] = p2; __hip_atomic_fetch_add(lcnt + i1, 1, __ATOMIC_RELAXED, __HIP_MEMORY_SCOPE_WORKGROUP); __hip_atomic_fetch_add(lcnt + i2, 1, __ATOMIC_RELAXED, __HIP_MEMORY_SCOPE_WORKGROUP); }
                const f32x4* gr = (const f32x4*)gn + lane; unsigned* o8 = (unsigned*)((unsigned char*)XBA + (size_t)m * DM) + lane;
#pragma unroll
                for (int j = 0; j < 8; ++j) { const f32x4 y = v[j] * rstd * gr[64 * j]; int t = __builtin_amdgcn_cvt_pk_fp8_f32(y[0], y[1], 0, false); t = __builtin_amdgcn_cvt_pk_fp8_f32(y[2], y[3], t, true); o8[64 * j] = (unsigned)t; } }
            __syncthreads();
            if (tid < NE) CNT[rb * NE + tid] = lcnt[tid];
            __syncthreads();
        }
        { const int gt = F.blk * NTHREADS + tid, NGT = F.G * NTHREADS; for (int i = gt; i < MOE_ROWS; i += NGT) { PERM[i] = 0; GATE[i] = 0.f; DEST[i] = -1; } }
    }
    SEAM(PH_ROUTE);

    if (IN(PH_SORT)) { PHASE_PTRS();
        LAS int* cl = (LAS int*)F.lds; LAS int* tot = cl + 2048; LAS int* pre = tot + 8; LAS int* base = pre + 8; LAS int* el = base + 16;
        for (int rb = F.blk; rb < M / 64; rb += F.G) {
            __syncthreads();
            for (int i = tid; i < 2048; i += NTHREADS) cl[i] = CNT[i];
            if (tid < 64) { el[2 * tid] = TOPI[2 * (rb * 64 + tid)]; el[2 * tid + 1] = TOPI[2 * (rb * 64 + tid) + 1]; }
            __syncthreads();
            if (tid < NE) { int t = 0, p = 0; for (int b = 0; b < 256; ++b) { const int c = cl[b * NE + tid]; t += c; if (b < rb) p += c; } tot[tid] = t; pre[tid] = p; }
            __syncthreads();
            if (tid == 0) { int bs = 0; for (int e = 0; e < NE; ++e) { base[e] = bs; bs += (tot[e] + 255) & ~255; } base[NE] = bs;
                if (rb == 0) { for (int e = 0; e < NE; ++e) for (int t = base[e] >> 8; t < (base[e + 1] >> 8); ++t) TILE[t] = e; TILE[159] = bs >> 8; } }
            __syncthreads();
            if (tid < 64) { const int m = rb * 64 + tid;
#pragma unroll
                for (int k = 0; k < 2; ++k) { const int e = el[2 * tid + k]; int rank = 0; for (int t = 0; t < 2 * tid; ++t) rank += (el[t] == e) ? 1 : 0;
                    const int pos = base[e] + pre[e] + rank; PERM[pos] = m; GATE[pos] = TOPP[2 * m + k]; DEST[pos] = 2 * m + k; } }
        }
        __syncthreads();
    }
    SEAM(PH_SORT);

    LAS int* tile_e = (LAS int*)(F.lds + LX_TILE);
    if (IN(PH_MOEUP) || IN(PH_MOEDN)) { PHASE_PTRS(); if (tid < 160) tile_e[tid] = TILE[tid]; __syncthreads(); }
    if (IN(PH_MOEUP)) { PHASE_PTRS();
        const int ntiles = __builtin_amdgcn_readfirstlane(tile_e[159]);
        pg8::GemmDesc g{XBA, W_MGU, DM / 2, DM / 2, DM / 2, 0x79797979, 0x7f7f7f7f}; pg8::MoeOrder S{ntiles, 2 * FE / 256, ntiles * (2 * FE / 256), F.G, F.blk, DM / 2, DM / 2, (size_t)FE * DM, tile_e, PERM, true};
        pg8::EpiSwiGLU<true, false> E{HMOE, FE, GATE, nullptr, 1.f, nullptr}; pg8::gemm_phase<pg8::EpiSwiGLU<true, false>, pg8::MoeOrder, true, true, 1>(F.lds, g, S, E, tid);
        if (OVERLAP_CONV) {
            const int nwg = ntiles * (2 * FE / 256), r = nwg % F.G, nidle = r ? F.G - r : F.G, me = r ? F.blk - r : F.blk;
            if (me >= 0) { LAS float* scr = (LAS float*)(F.lds + F.wave * 16384);
                for (int it = me * NWAVES + F.wave; it < 8 * CI_MDN; it += nidle * NWAVES) conv_item(A_, ws, 16 * CI_MGU + it, scr, lane); } }
    }
    SEAM(PH_MOEUP);

    if (IN(PH_MOEDN)) { PHASE_PTRS();
        const int ntiles = __builtin_amdgcn_readfirstlane(tile_e[159]);
        pg8::GemmDesc g{HMOE, W_MDN, FE / 2, FE / 2, FE / 2, 0x79797979, 0x7d7d7d7d}; pg8::MoeOrder S{ntiles, DM / 256, ntiles * (DM / 256), F.G, F.blk, FE / 2, FE / 2, (size_t)DM * FE / 2, tile_e, PERM, false};
        pg8::EpiScatter E{YMOE, DEST}; pg8::gemm_phase<pg8::EpiScatter, pg8::MoeOrder, true, false, 1>(F.lds, g, S, E, tid);
    }
    SEAM(PH_MOEDN);
    if (IN(PH_FINAL)) { PHASE_PTRS();
        const float* gf = AIN(I_FNORM);
        for (int m = gw; m < M; m += NGW) {
            const res_t* xr = XR + (size_t)m * DM; f32x4* orow = (f32x4*)(A_->out + (size_t)m * DM) + lane; const u32x2* y0 = (const u32x2*)(YMOE + (size_t)(2 * m) * DM) + lane; const u32x2* y1 = (const u32x2*)(YMOE + (size_t)(2 * m + 1) * DM) + lane;
            f32x4 v[8]; float s = 0.f;
#pragma unroll
            for (int j = 0; j < 8; ++j) { const u32x2 a = y0[64 * j], b = y1[64 * j]; f32x4 t = ldres4(xr + 4 * (lane + 64 * j));
                t[0] += bflo(a.x) + bflo(b.x); t[1] += bfhi(a.x) + bfhi(b.x); t[2] += bflo(a.y) + bflo(b.y); t[3] += bfhi(a.y) + bfhi(b.y); v[j] = t;
                s += (t[0] * t[0] + t[1] * t[1]) + (t[2] * t[2] + t[3] * t[3]); }
            const float rstd = 1.0f / sqrtf(wave_sum(s) * (1.f / DM) + EPS); const f32x4* gr = (const f32x4*)gf + lane;
#pragma unroll
            for (int j = 0; j < 8; ++j) orow[64 * j] = v[j] * rstd * gr[64 * j];
        }
    }
#undef IN
#undef SEAM
}

extern "C" void kernel_launch(void* const* d_in, const int* in_sizes, int n_in, void* d_out, int out_size, void* d_ws, size_t ws_size, hipStream_t stream) {
    static int grid = 0;
    if (grid == 0) {
        if (n_in != 22 || in_sizes[0] != M * DM || out_size != M * DM || ws_size < WS_END) { fprintf(stderr, "kernel_launch: unexpected shapes / workspace (n_in %d, ws %zu, need %zu)\n", n_in, ws_size, (size_t)WS_END); grid = -1; return; }
        int dev = 0, cus = 0;
        if (hipGetDevice(&dev) != hipSuccess || hipDeviceGetAttribute(&cus, hipDeviceAttributeMultiprocessorCount, dev) != hipSuccess) { grid = -1; return; }
        if (hipFuncSetAttribute((const void*)fwd_kernel, hipFuncAttributeMaxDynamicSharedMemorySize, LDS_BYTES) != hipSuccess) { fprintf(stderr, "kernel_launch: hipFuncSetAttribute failed\n"); grid = -1; return; }
        int per_cu = 0; (void)hipOccupancyMaxActiveBlocksPerMultiprocessor(&per_cu, (const void*)fwd_kernel, NTHREADS, LDS_BYTES); (void)hipGetLastError();
        if (per_cu < 1) fprintf(stderr, "kernel_launch: occupancy query reports %d blocks per CU\n", per_cu);
        grid = cus;
    }
    if (grid < 0) return;
    (void)hipMemsetAsync((char*)d_ws + WS_CTL, 0, CTL_ZERO_BYTES, stream);
    Args a{};
    for (int i = 0; i < 22; ++i) a.in[i] = (const float*)d_in[i];
    a.out = (float*)d_out; a.ws = (unsigned char*)d_ws;
    for (int k = 0; k < 32; ++k) a.inv_freq[k] = (float)pow(10000.0, -(double)(2 * k) / 64.0);
#ifndef MAX_PHASE
#define MAX_PHASE NPH
#endif
#if MK_PER_PHASE
    for (int ph = 0; ph < MAX_PHASE; ++ph) { a.ph_lo = ph; a.ph_hi = ph + 1; hipLaunchKernelGGL(fwd_kernel, dim3(grid), dim3(NTHREADS), LDS_BYTES, stream, a);
        if ((PROBE_MASK >> ph) & 1) hipLaunchKernelGGL(fwd_kernel, dim3(grid), dim3(NTHREADS), LDS_BYTES, stream, a); }
#else
    a.ph_lo = 0; a.ph_hi = NPH; hipLaunchKernelGGL(fwd_kernel, dim3(grid), dim3(NTHREADS), LDS_BYTES, stream, a);
#endif
}
```
